# Optimizing an MI355X kernel written in HIP

```python
import math
import jax, jax.numpy as jnp
from jax import lax
import numpy as np

D_MODEL = 4096
BATCH = 4
SEQ = 4096
DEPTH = 1

CHUNK = 64
D_FF = 256 * ((8 * D_MODEL // 3 + 255) // 256)
GMLP_WIDTH = D_MODEL // 2
GMLP_GROUP_DIM = 128
GMLP_GROUPS = GMLP_WIDTH // GMLP_GROUP_DIM
GMLP_BLOCK = 128
HEAD_DIM = 128
ATTN_HEADS = (D_MODEL // 2) // HEAD_DIM
ATTN_WIDTH = ATTN_HEADS * HEAD_DIM
IDX_HEADS = D_MODEL // 128
IDX_DIM = 64
TOPK_MAX = 256
Q_BLOCK = 128
ROPE_THETA = 10000.0
EPS = 1e-6
SPLITS = (GMLP_WIDTH, GMLP_WIDTH, ATTN_WIDTH, HEAD_DIM, HEAD_DIM,
          IDX_HEADS * IDX_DIM, IDX_DIM, IDX_HEADS, D_MODEL, D_MODEL)
IN_WIDTH = sum(SPLITS)

kernel_name = "hybrid_gmlp_dsa_macaron_block"


def rms_norm(x, g):
    xf = x.astype(jnp.float32)
    y = xf * lax.rsqrt(jnp.mean(xf * xf, axis=-1, keepdims=True) + EPS)
    return (y * g.astype(jnp.float32)).astype(x.dtype)


def rope_tables(seq, dim):
    inv = ROPE_THETA ** (-jnp.arange(0, dim, 2, dtype=jnp.float32) / dim)
    ang = jnp.arange(seq, dtype=jnp.float32)[:, None] * inv[None, :]
    return jnp.cos(ang), jnp.sin(ang)


def apply_rope(x, cos, sin):
    if x.ndim == 4:
        cos, sin = cos[:, None, :], sin[:, None, :]
    xf = x.astype(jnp.float32)
    x1, x2 = jnp.split(xf, 2, axis=-1)
    out = jnp.concatenate([x1 * cos - x2 * sin, x1 * sin + x2 * cos], axis=-1)
    return out.astype(x.dtype)


def swiglu(x, w1, w3, w2):
    return (jax.nn.silu(x @ w1) * (x @ w3)) @ w2


def gmlp_spatial_gating(u, v, v_gain, ws, bs):
    B, S, _ = u.shape
    u = jax.nn.gelu(u, approximate=False)
    v = rms_norm(jax.nn.gelu(v, approximate=False), v_gain)
    n_blk = S // GMLP_BLOCK
    pos_chunk = jnp.arange(GMLP_BLOCK) // CHUNK
    mask = pos_chunk[None, :] <= pos_chunk[:, None]
    ws_m = jnp.where(mask[None], ws, jnp.zeros_like(ws))
    vb = v.reshape(B, n_blk, GMLP_BLOCK, GMLP_GROUPS, GMLP_GROUP_DIM)
    mixed = jnp.einsum('gts,bnsgc->bntgc', ws_m, vb) + bs.T[None, None, :, :, None]
    return u * mixed.reshape(B, S, GMLP_WIDTH)


def dsa_attention(q, k, v, q_idx, k_idx, w_idx):
    B, S, H, hd = q.shape
    n_blk = S // Q_BLOCK
    top = min(TOPK_MAX, S // 4)
    key_chunk = jnp.arange(S) // CHUNK
    gather = jax.vmap(lambda tab, ids: tab[ids])

    def one_block(args):
        qb, qib, wb, blk = args
        q_chunk = (blk * Q_BLOCK + jnp.arange(Q_BLOCK)) // CHUNK
        rel = jax.nn.relu(jnp.einsum('bthd,bsd->bths', qib, k_idx).astype(jnp.float32))
        score = jnp.einsum('bth,bths->bts', wb.astype(jnp.float32), rel)
        adm = key_chunk[None, :] <= q_chunk[:, None]
        score = jnp.where(adm[None], score, -jnp.inf)
        _, sel = lax.top_k(score, top)
        valid = (sel // CHUNK) <= q_chunk[None, :, None]
        k_sel = gather(k, sel)
        v_sel = gather(v, sel)
        logits = jnp.einsum('bthd,btkd->bthk', qb, k_sel).astype(jnp.float32) * (hd ** -0.5)
        logits = jnp.where(valid[:, :, None, :], logits, -jnp.inf)
        p = jax.nn.softmax(logits, axis=-1).astype(v.dtype)
        return jnp.einsum('bthk,btkd->bthd', p, v_sel)

    to_blocks = lambda a: a.reshape(B, n_blk, Q_BLOCK, *a.shape[2:]).swapaxes(0, 1)
    out = lax.map(one_block, (to_blocks(q), to_blocks(q_idx), to_blocks(w_idx), jnp.arange(n_blk)))
    return out.swapaxes(0, 1).reshape(B, S, H * hd)


def setup_inputs(seed: int = 0) -> dict:
    key = jax.random.key(seed)
    ks = jax.random.split(key, 24)
    L = DEPTH
    nrm = lambda k, shape, s: jax.random.normal(k, shape, jnp.float32) * s
    gain = lambda k, n: 1.0 + nrm(k, (L, n), 0.02)
    return {
        "x": nrm(ks[0], (BATCH, SEQ, D_MODEL), 1.0),
        "ffn1_norm": gain(ks[1], D_MODEL),
        "ffn1_w1": nrm(ks[2], (L, D_MODEL, D_FF), D_MODEL ** -0.5),
        "ffn1_w3": nrm(ks[3], (L, D_MODEL, D_FF), D_MODEL ** -0.5),
        "ffn1_w2": nrm(ks[4], (L, D_FF, D_MODEL), D_FF ** -0.5),
        "mix_norm": gain(ks[5], D_MODEL),
        "w_in": nrm(ks[6], (L, D_MODEL, IN_WIDTH), D_MODEL ** -0.5),
        "gate_bias": nrm(ks[7], (L, 2 * D_MODEL), 0.02),
        "gmlp_v_norm": gain(ks[8], GMLP_WIDTH),
        "gmlp_ws": nrm(ks[9], (L, GMLP_GROUPS, GMLP_BLOCK, GMLP_BLOCK), GMLP_BLOCK ** -0.5),
        "gmlp_bs": 1.0 + nrm(ks[10], (L, GMLP_GROUPS, GMLP_BLOCK), 0.02),
        "q_norm": gain(ks[11], HEAD_DIM),
        "k_norm": gain(ks[12], HEAD_DIM),
        "idx_k_norm": gain(ks[13], IDX_DIM),
        "w_br_a": nrm(ks[14], (L, GMLP_WIDTH, D_MODEL), GMLP_WIDTH ** -0.5),
        "w_br_b": nrm(ks[15], (L, ATTN_WIDTH, D_MODEL), ATTN_WIDTH ** -0.5),
        "w_out": nrm(ks[16], (L, D_MODEL, D_MODEL), D_MODEL ** -0.5),
        "ffn2_norm": gain(ks[17], D_MODEL),
        "ffn2_w1": nrm(ks[18], (L, D_MODEL, D_FF), D_MODEL ** -0.5),
        "ffn2_w3": nrm(ks[19], (L, D_MODEL, D_FF), D_MODEL ** -0.5),
        "ffn2_w2": nrm(ks[20], (L, D_FF, D_MODEL), D_FF ** -0.5),
    }


def reference(x, ffn1_norm, ffn1_w1, ffn1_w3, ffn1_w2, mix_norm, w_in, gate_bias,
              gmlp_v_norm, gmlp_ws, gmlp_bs, q_norm, k_norm, idx_k_norm,
              w_br_a, w_br_b, w_out, ffn2_norm, ffn2_w1, ffn2_w3, ffn2_w2):
    B, S, _ = x.shape
    cos_a, sin_a = rope_tables(S, HEAD_DIM)
    cos_i, sin_i = rope_tables(S, IDX_DIM)
    split_at = [int(c) for c in np.cumsum(SPLITS)[:-1]]
    idx_scale = (IDX_HEADS ** -0.5) * (IDX_DIM ** -0.5)
    h = x
    for l in range(DEPTH):
        h = h + 0.5 * swiglu(rms_norm(h, ffn1_norm[l]), ffn1_w1[l], ffn1_w3[l], ffn1_w2[l])
        n = rms_norm(h, mix_norm[l])
        z = n @ w_in[l]
        (u_a, v_a, q, k, v, q_i, k_i, w_i, g_a, g_b) = jnp.split(z, split_at, axis=-1)
        y_a = gmlp_spatial_gating(u_a, v_a, gmlp_v_norm[l], gmlp_ws[l], gmlp_bs[l])
        q = apply_rope(rms_norm(q.reshape(B, S, ATTN_HEADS, HEAD_DIM), q_norm[l]), cos_a, sin_a)
        k = apply_rope(rms_norm(k, k_norm[l]), cos_a, sin_a)
        q_i = apply_rope(q_i.reshape(B, S, IDX_HEADS, IDX_DIM), cos_i, sin_i)
        k_i = apply_rope(rms_norm(k_i, idx_k_norm[l]), cos_i, sin_i)
        y_b = dsa_attention(q, k, v, q_i, k_i, w_i * idx_scale)
        gates = jax.nn.sigmoid((jnp.concatenate([g_a, g_b], axis=-1) + gate_bias[l]).astype(jnp.float32)).astype(h.dtype)
        gate_a, gate_b = jnp.split(gates, 2, axis=-1)
        m = gate_a * (y_a @ w_br_a[l]) + gate_b * (y_b @ w_br_b[l])
        h = h + m @ w_out[l]
        h = h + 0.5 * swiglu(rms_norm(h, ffn2_norm[l]), ffn2_w1[l], ffn2_w3[l], ffn2_w2[l])
    return h
```

```cpp
#include <hip/hip_runtime.h>
#include <cstdio>
#include <cstdint>


#define LAS __attribute__((address_space(3)))
typedef unsigned short bf16_t;
typedef short bf16x8 __attribute__((ext_vector_type(8)));
typedef float f32x4 __attribute__((ext_vector_type(4)));
typedef float f32x16 __attribute__((ext_vector_type(16)));
typedef unsigned u32x4 __attribute__((ext_vector_type(4)));
typedef unsigned u32x2 __attribute__((ext_vector_type(2)));

constexpr int DM = 4096, NBATCH = 4, SEQ = 4096, MROWS = NBATCH * SEQ;
constexpr int DFF = 11008, GW = 2048, AW = 2048, HD = 128, NH = 16, IH = 32, IDM = 64;
constexpr int NIN = 16896;
constexpr int NGATE = 8192;
constexpr int KVW = 352;
constexpr float EPS = 1e-6f;
constexpr float IDX_SCALE = 0.02209708691207961f;
constexpr float LOG2E = 1.4426950408889634f;
#ifndef USE_FP8_UP2
#define USE_FP8_UP2 1
#endif
#ifndef USE_FP8_DOWN1
#define USE_FP8_DOWN1 0
#endif
#ifndef USE_FP8_DOWN
#define USE_FP8_DOWN 1
#endif
constexpr float H8_SCALE = 8.0f, WIN8_SCALE = 64.0f;
constexpr int NIN_A = 42 * 256, NIN_B = 24 * 256;
constexpr float G8_SCALE = 4.0f, W8_SCALE = 128.0f;

constexpr size_t MiB = 1u << 20;
constexpr size_t WS_CTL = 0, CTL_ZERO_BYTES = 256 * 1024;
constexpr size_t CTL_BAR_BYTE = 16384;
constexpr size_t CTL_SS2 = 64 * 1024, CTL_SS3 = 128 * 1024, CTL_SSV = 192 * 1024;
constexpr size_t WS_W13A = 1 * MiB;
constexpr size_t WS_W2A = WS_W13A + 172 * MiB;
constexpr size_t WS_WIN = WS_W2A + 86 * MiB;
constexpr size_t WS_WA = WS_WIN + 132 * MiB;
constexpr size_t WS_WB = WS_WA + 16 * MiB;
constexpr size_t WS_WOUT = WS_WB + 16 * MiB;
constexpr size_t WS_W13B = WS_WOUT + 32 * MiB;
constexpr size_t WS_W2B = WS_W13B + 172 * MiB;
constexpr size_t WS_R1 = WS_W2B + 86 * MiB;
constexpr size_t WS_R2 = WS_R1 + 128 * MiB;
constexpr size_t WS_R3 = WS_R2 + 344 * MiB;
constexpr size_t WS_R4 = WS_R3 + 256 * MiB;
constexpr size_t WS_U = WS_R2, WS_V = WS_R2 + 64 * MiB, WS_QR = WS_R2 + 128 * MiB, WS_QIR = WS_R2 + 192 * MiB, WS_KVR = WS_R2 + 256 * MiB, WS_YA = WS_R2 + 279 * MiB;
static_assert((size_t)MROWS * KVW * 4 <= 23 * MiB && WS_YA + 64 * MiB <= WS_R3, "R2 overlay");
constexpr size_t WS_YB = WS_R4, WS_KN = WS_R4 + 64 * MiB, WS_VB = WS_KN + 4 * MiB, WS_KIN = WS_VB + 4 * MiB, WS_WI = WS_KIN + 2 * MiB;
constexpr size_t WS_COSA = WS_WI + 2 * MiB, WS_SINA = WS_COSA + 1 * MiB, WS_COSI = WS_SINA + 1 * MiB, WS_SINI = WS_COSI + 512 * 1024, WS_WS16 = WS_SINI + 512 * 1024;
constexpr size_t WS_WINB8 = WS_WIN + 84 * MiB;
constexpr size_t WS_H2B8 = WS_R3 + 128 * MiB;
constexpr size_t WS_H1B8 = WS_YB;
constexpr size_t WS_SS2P = WS_WS16 + 1 * MiB, WS_SS3P = WS_SS2P + 4 * MiB, WS_SSVP = WS_SS3P + 4 * MiB;
constexpr size_t WS_END = WS_SSVP + 2 * MiB;
static_assert(WS_END <= (size_t)1600 * MiB, "workspace budget");

constexpr int LDS_SC = 0;
constexpr int LDS_KST = 131072;
constexpr int KPITCH = 144, KSTG = 64 * KPITCH;
constexpr int LDS_SEL = LDS_KST + 3 * KSTG;
constexpr int LDS_RS = 131072;
constexpr int MISC_OFF = LDS_SEL + 4096;
constexpr int LDS_BYTES = MISC_OFF + 128;
static_assert(LDS_BYTES <= 160 * 1024 && 3 * KSTG >= 16384, "LDS map");

__device__ __forceinline__ unsigned cvt_pk_bf16(float lo, float hi) { unsigned r; asm volatile("s_nop 0\n\tv_cvt_pk_bf16_f32 %0, %1, %2" : "=v"(r) : "v"(lo), "v"(hi)); return r; }
__device__ __forceinline__ float bf_lo(unsigned w) { return __uint_as_float(w << 16); }
__device__ __forceinline__ float bf_hi(unsigned w) { return __uint_as_float(w & 0xffff0000u); }
__device__ __forceinline__ float wave_sum(float v) {
#pragma unroll
    for (int o = 1; o < 64; o <<= 1) v += __shfl_xor(v, o);
    return v;
}
__device__ __forceinline__ float sigmoid_f(float z) { return __builtin_amdgcn_rcpf(1.0f + __builtin_amdgcn_exp2f(-z * LOG2E)); }
typedef float f32x2 __attribute__((ext_vector_type(2)));
__device__ __forceinline__ f32x2 gelu_pk(f32x2 v) {
    const f32x2 av = __builtin_elementwise_abs(v), d = av * 0.2316418882f + 1.0f;
    f32x2 t; t.x = __builtin_amdgcn_rcpf(d.x); t.y = __builtin_amdgcn_rcpf(d.y);
    f32x2 q = t * 0.5307027145f + (-0.7265760135f); q = q * t + 0.7107068705f; q = q * t + (-0.142248368f); q = q * t + 0.127414796f; q = q * t;
    const f32x2 s = (v * v) * (-0.72134752044f);
    f32x2 e; e.x = __builtin_amdgcn_exp2f(s.x); e.y = __builtin_amdgcn_exp2f(s.y);
    const f32x2 m = v * (q * e), r = v - m;
    f32x2 o; o.x = v.x < 0.f ? m.x : r.x; o.y = v.y < 0.f ? m.y : r.y; return o;
}
__device__ __forceinline__ f32x4 gelu4(f32x4 v) { const f32x2 a = gelu_pk((f32x2){v[0], v[1]}), b = gelu_pk((f32x2){v[2], v[3]}); return (f32x4){a.x, a.y, b.x, b.y}; }

#define XB_TMO      128
#define XB_XCNT(j)  (256  + 64 * (j))
#define XB_XSUB(j)  (1280 + 64 * (j))
#define XB_XGEN(j)  (2304 + 64 * (j))
#define XB_TOP      3328
#define XB_TOPGEN   3392
#define XCD_BAR_WORDS 3456
#define XB_SPIN_CAP (1u << 18)
__device__ __forceinline__ unsigned xb_ld(unsigned* p)              { return __hip_atomic_load(p, __ATOMIC_RELAXED, __HIP_MEMORY_SCOPE_AGENT); }
__device__ __forceinline__ unsigned xb_add(unsigned* p, unsigned v) { return __hip_atomic_fetch_add(p, v, __ATOMIC_RELAXED, __HIP_MEMORY_SCOPE_AGENT); }
__device__ __forceinline__ unsigned xb_xcc_id() { return (unsigned)__builtin_amdgcn_s_getreg((3 << 11) | 20) & 0xFu; }
#define XB_SPIN(cond, bar) do { unsigned _sp = 0; while (cond) { __builtin_amdgcn_s_sleep(1); \
    if ((++_sp & 255u) == 0u) { if (xb_ld(&(bar)[XB_TMO])) break; if (_sp > XB_SPIN_CAP) { atomicAdd(&(bar)[XB_TMO], 1u); break; } } } } while (0)
#define XB_DONE XCD_BAR_WORDS
__device__ unsigned g_bar[XCD_BAR_WORDS + 64];
struct XcdBarrier { unsigned* bar; unsigned x; volatile LAS unsigned* st; };
__device__ __forceinline__ void xb_st0(unsigned* p) { __hip_atomic_store(p, 0u, __ATOMIC_RELAXED, __HIP_MEMORY_SCOPE_AGENT); }
__device__ __forceinline__ void xcd_barrier_retire(unsigned* bar) {
    __syncthreads();
    if (threadIdx.x == 0) {
        const unsigned G = gridDim.x * gridDim.y * gridDim.z;
        if (xb_add(&bar[XB_DONE], 1u) == G - 1u) {
#pragma unroll
            for (int j = 0; j < 16; ++j) { xb_st0(&bar[XB_XCNT(j)]); xb_st0(&bar[XB_XSUB(j)]); xb_st0(&bar[XB_XGEN(j)]); }
            xb_st0(&bar[XB_TOP]); xb_st0(&bar[XB_TOPGEN]); xb_st0(&bar[XB_TMO]); xb_st0(&bar[XB_DONE]);
        }
    }
}
__device__ __forceinline__ XcdBarrier xcd_barrier_post(unsigned* bar, volatile LAS unsigned* st) {
    XcdBarrier b; b.bar = bar; b.x = xb_xcc_id(); b.st = st;
    if (threadIdx.x == 0) st[2] = xb_add(&bar[XB_XCNT(b.x)], 1u);
    return b;
}
__device__ __forceinline__ void xcd_barrier_complete(unsigned* bar, unsigned x, unsigned& nloc, unsigned& nx) {
    const unsigned G = gridDim.x * gridDim.y * gridDim.z;
    unsigned sum, cnt, mine, sp = 0u;
    for (;;) {
        sum = 0u; cnt = 0u; mine = 0u;
#pragma unroll
        for (unsigned j = 0; j < 16; ++j) { const unsigned c = xb_ld(&bar[XB_XCNT(j)]); sum += c; cnt += (c > 0u) ? 1u : 0u; mine = (j == x) ? c : mine; }
        if (sum == G) break;
        __builtin_amdgcn_s_sleep(1);
        if ((++sp & 255u) == 0u) { if (xb_ld(&bar[XB_TMO])) break; if (sp > XB_SPIN_CAP) { atomicAdd(&bar[XB_TMO], 1u); break; } }
    }
    nloc = mine > 0u ? mine : 1u; nx = cnt > 0u ? cnt : 1u;
}
__device__ __forceinline__ void xcd_barrier(const XcdBarrier& b) {
    asm volatile("s_waitcnt vmcnt(0)" ::: "memory");
    __syncthreads();
    if (threadIdx.x == 0) {
        unsigned* bar = b.bar;
        __builtin_amdgcn_s_waitcnt(0);
        unsigned nloc = b.st[0], nx = b.st[1];
        if (nloc == 0u) { xcd_barrier_complete(bar, b.x, nloc, nx); b.st[0] = nloc; b.st[1] = nx; }
        const unsigned old = xb_add(&bar[XB_XSUB(b.x)], 1u);
        const unsigned gen = old / nloc;
        if (old + 1u == (gen + 1u) * nloc) {
            __builtin_amdgcn_fence(__ATOMIC_RELEASE, "agent");
            asm volatile("s_waitcnt vmcnt(0)" ::: "memory");
            const unsigned og = xb_add(&bar[XB_TOP], 1u);
            const unsigned tg = og / nx;
            if (og + 1u == (tg + 1u) * nx) xb_add(&bar[XB_TOPGEN], 1u);
            else XB_SPIN(xb_ld(&bar[XB_TOPGEN]) == tg, bar);
            __builtin_amdgcn_fence(__ATOMIC_ACQUIRE, "agent");
            xb_add(&bar[XB_XGEN(b.x)], 1u);
            asm volatile("s_waitcnt vmcnt(0)" ::: "memory");
        } else {
            XB_SPIN(xb_ld(&bar[XB_XGEN(b.x)]) == gen, bar);
            __builtin_amdgcn_fence(__ATOMIC_ACQUIRE, "agent");
            asm volatile("s_waitcnt vmcnt(0)" ::: "memory");
        }
    }
    __syncthreads();
}

namespace pg8 {
constexpr int BM = 256, BK = 64, HALF = 128, HTB = HALF * BK * 2, STAGE_BYTES = 8 * HTB, NXCD = 8, WGM = 8;
__device__ __forceinline__ int lds_byte(int r, int c) { const int st = (r >> 4) * 2 + (c >> 5), rr = r & 15, cc = c & 31, ob = rr * 64 + cc * 2; return st * 1024 + (ob ^ (((ob >> 9) & 1) << 5)); }
__device__ __forceinline__ void stage_rc(int b, int& R, int& C) { const int st = b / 1024, sb = b % 1024, swz = sb ^ (((sb >> 9) & 1) << 5); R = (st >> 1) * 16 + swz / 64; C = (st & 1) * 32 + (swz % 64) / 2; }
__device__ __forceinline__ int perm32(int rho) { const int n = rho >> 4, i = rho & 15; return 8 * (i >> 2) + 4 * n + (i & 3); }
struct Unit { int pm, pn, seg; };
struct Gemm { const bf16_t* A0; const bf16_t* B0; const bf16_t* A1; const bf16_t* B1; int K; };
template <int NSEG> struct TileOrder {
    int nM, nN, nwg, G, c;
    __device__ __forceinline__ void init(int M, int N, int G_, int c_) { nM = M / BM; nN = N / BM; nwg = nM * nN; G = G_; c = c_; }
    __device__ __forceinline__ bool next(int i, Unit& u) const {
        const int ti = i / NSEG; u.seg = i % NSEG;
        const long L = (long)ti * G + c; if (L >= nwg) return false;
        int wgid = (int)L; { const int q = nwg / NXCD, r = nwg % NXCD, xcd = wgid % NXCD, off = wgid / NXCD; wgid = (xcd < r ? xcd * (q + 1) : r * (q + 1) + (xcd - r) * q) + off; }
        const int nig = WGM * nN, gid = wgid / nig, fm = gid * WGM, gsz = (nM - fm) < WGM ? (nM - fm) : WGM;
        u.pm = fm + ((wgid % nig) % gsz); u.pn = (wgid % nig) / gsz; return true;
    }
};
struct SplitOrder {
    int pm, base, cnt;
    __device__ __forceinline__ void init(int c, int nlo, int nhi) { const int k = c >> 6; pm = 8 * (c & 7) + ((c >> 3) & 7); base = k < 2 ? k * nlo : 2 * nlo + (k - 2) * nhi; cnt = k < 2 ? nlo : nhi; }
    __device__ __forceinline__ bool next(int i, Unit& u) const { if (i >= cnt) return false; u.pm = pm; u.pn = base + i; u.seg = 0; return true; }
};
template <int M, int N, int NLO, int NHI> struct SplitOrTile {
    int G, c;
    __device__ __forceinline__ bool next(int i, Unit& u) const {
        if (G == 256) { SplitOrder s; s.init(c, NLO, NHI); return s.next(i, u); }
        TileOrder<1> t; t.init(M, N, G, c); return t.next(i, u);
    }
};
typedef int v8i_t __attribute__((ext_vector_type(8)));
typedef int v4i_t __attribute__((ext_vector_type(4)));
__device__ __forceinline__ v8i_t cat8(bf16x8 a, bf16x8 b) { const v4i_t x = __builtin_bit_cast(v4i_t, a), y = __builtin_bit_cast(v4i_t, b); return __builtin_shufflevector(x, y, 0, 1, 2, 3, 4, 5, 6, 7); }
template <class Epi, class Sched, bool FP8 = false>
__device__ __forceinline__ void gemm_phase(LAS unsigned char* lds, const Gemm g, const Sched& S, const Epi& E) {
    const int tid = threadIdx.x, wid = __builtin_amdgcn_readfirstlane(tid >> 6), lane = tid & 63, wr = wid >> 2, wc = wid & 3, fr = lane & 15, fq = lane >> 4;
    const int K = g.K, nt = K / BK;
    unsigned voffA[2], voffB[2];
#pragma unroll
    for (int i = 0; i < 2; ++i) { int R, C; stage_rc(tid * 16 + i * 8192, R, C); const int Rb = (R & ~31) + perm32(R & 31);
        voffA[i] = (unsigned)(R * K + C) * 2u; voffB[i] = (unsigned)(Rb * K + C) * 2u; }
    const size_t kstep = (size_t)(BK * 2);
    const size_t hstep = (size_t)HALF * K * 2;
    const size_t tstep = 2 * hstep;
    const unsigned ldsw = (unsigned)wid * 1024u;
    const int aoff = lds_byte(wr * 64 + fr, fq * 8), boff = lds_byte(wc * 32 + fr, fq * 8);
#define PG8_SA(b, h) (((b) * 2 + (h)) * HTB)
#define PG8_SB(b, h) ((4 + (b) * 2 + (h)) * HTB)
#define PG8_STAGE(bufoff, gbase, voff) do { _Pragma("unroll") for (int _i = 0; _i < 2; ++_i) \
        __builtin_amdgcn_global_load_lds((const unsigned*)((const char*)(gbase) + (voff)[_i]), (LAS unsigned*)(lds + (bufoff) + ldsw + _i * 8192), 16, 0, 0); } while (0)
#define PG8_LDA(dst, b, h) do { _Pragma("unroll") for (int m = 0; m < 4; ++m) { const bf16x8 _x0 = *(const LAS bf16x8*)(lds + PG8_SA(b, h) + aoff + m * 2048), _x1 = *(const LAS bf16x8*)(lds + PG8_SA(b, h) + aoff + m * 2048 + 1024); \
        if constexpr (FP8) dst##8[m] = cat8(_x0, _x1); else { dst[m][0] = _x0; dst[m][1] = _x1; } } } while (0)
#define PG8_LDB(dst, b, h) do { _Pragma("unroll") for (int n = 0; n < 2; ++n) { const bf16x8 _x0 = *(const LAS bf16x8*)(lds + PG8_SB(b, h) + boff + n * 2048), _x1 = *(const LAS bf16x8*)(lds + PG8_SB(b, h) + boff + n * 2048 + 1024); \
        if constexpr (FP8) dst##8[n] = cat8(_x0, _x1); else { dst[n][0] = _x0; dst[n][1] = _x1; } } } while (0)
#define PG8_MMA(ai, bj, At, Bt) do { __builtin_amdgcn_s_setprio(1); if constexpr (FP8) { _Pragma("unroll") for (int m = 0; m < 4; ++m) _Pragma("unroll") for (int n = 0; n < 2; ++n) \
        asm volatile("v_mfma_f32_16x16x128_f8f6f4 %0, %1, %2, %0" : "+v"(acc[ai][bj][m][n]) : "v"(Bt##8[n]), "v"(At##8[m])); } \
        else { _Pragma("unroll") for (int m = 0; m < 4; ++m) _Pragma("unroll") for (int n = 0; n < 2; ++n) _Pragma("unroll") for (int k = 0; k < 2; ++k) \
        acc[ai][bj][m][n] = __builtin_amdgcn_mfma_f32_16x16x32_bf16(Bt[n][k], At[m][k], acc[ai][bj][m][n], 0, 0, 0); } __builtin_amdgcn_s_setprio(0); } while (0)
#define PG8_WAIT_V(n) asm volatile("s_waitcnt vmcnt(" #n ")" ::: "memory")
#define PG8_WAIT_L(n) asm volatile("s_waitcnt lgkmcnt(" #n ")" ::: "memory")
#define PG8_BAR __builtin_amdgcn_s_barrier()
#define PG8_SCHED __builtin_amdgcn_sched_barrier(0)
    Unit cur, nxt; int ui = 0;
    if (!S.next(0, cur)) return;
    f32x4 acc[2][2][4][2];
#pragma unroll
    for (int a = 0; a < 2; ++a)
#pragma unroll
        for (int b = 0; b < 2; ++b)
#pragma unroll
            for (int m = 0; m < 4; ++m)
#pragma unroll
                for (int n = 0; n < 2; ++n) acc[a][b][m][n] = (f32x4){0.f, 0.f, 0.f, 0.f};
    bf16x8 At[4][2], B0[2][2], B1[2][2];
    v8i_t At8[4], B08[2], B18[2];
    const char* cA = (const char*)(cur.seg ? g.A1 : g.A0) + (size_t)cur.pm * tstep; const char* cB = (const char*)(cur.seg ? g.B1 : g.B0) + (size_t)cur.pn * tstep;
    PG8_STAGE(PG8_SB(0, 0), cB, voffB); PG8_STAGE(PG8_SB(0, 1), cB + hstep, voffB); PG8_STAGE(PG8_SA(0, 0), cA, voffA); PG8_STAGE(PG8_SA(0, 1), cA + hstep, voffA);
    if (wr == 1) PG8_BAR;
    PG8_WAIT_V(2); PG8_BAR;
    PG8_STAGE(PG8_SB(1, 0), cB + kstep, voffB); PG8_STAGE(PG8_SA(1, 0), cA + kstep, voffA); PG8_STAGE(PG8_SB(1, 1), cB + hstep + kstep, voffB);
    PG8_WAIT_V(6); PG8_BAR;
    for (;;) {
        const bool has_next = S.next(ui + 1, nxt);
        const char* nA = has_next ? (const char*)(nxt.seg ? g.A1 : g.A0) + (size_t)nxt.pm * tstep : cA; const char* nB = has_next ? (const char*)(nxt.seg ? g.B1 : g.B0) + (size_t)nxt.pn * tstep : cB;
        for (int t = 0; t < nt; t += 2) {
            const bool last = (t == nt - 2);
            const char* a1 = cA + (size_t)(t + 1) * kstep;
            const char* a2 = last ? nA : cA + (size_t)(t + 2) * kstep; const char* b2 = last ? nB : cB + (size_t)(t + 2) * kstep;
            const char* a3 = a2 + kstep; const char* b3 = b2 + kstep;
            PG8_LDB(B0, 0, 0); PG8_LDB(B1, 0, 1); PG8_SCHED; PG8_LDA(At, 0, 0); PG8_STAGE(PG8_SA(1, 1), a1 + hstep, voffA);
            PG8_WAIT_V(8); PG8_WAIT_L(0); PG8_BAR; PG8_MMA(0, 0, At, B0); PG8_MMA(0, 1, At, B1); PG8_BAR; PG8_SCHED;
            PG8_LDA(At, 0, 1); PG8_STAGE(PG8_SB(0, 0), b2, voffB); PG8_STAGE(PG8_SB(0, 1), b2 + hstep, voffB); PG8_STAGE(PG8_SA(0, 0), a2, voffA);
            PG8_WAIT_V(8); PG8_WAIT_L(0); PG8_BAR; PG8_MMA(1, 0, At, B0); PG8_MMA(1, 1, At, B1); PG8_BAR; PG8_SCHED;
            PG8_LDB(B0, 1, 0); PG8_LDB(B1, 1, 1); PG8_SCHED; PG8_LDA(At, 1, 0); PG8_STAGE(PG8_SA(0, 1), a2 + hstep, voffA);
            PG8_WAIT_V(8); PG8_WAIT_L(0); PG8_BAR; PG8_MMA(0, 0, At, B0); PG8_MMA(0, 1, At, B1); PG8_BAR; PG8_SCHED;
            PG8_LDA(At, 1, 1); PG8_STAGE(PG8_SB(1, 0), b3, voffB); PG8_STAGE(PG8_SB(1, 1), b3 + hstep, voffB); PG8_STAGE(PG8_SA(1, 0), a3, voffA);
            PG8_WAIT_V(8); PG8_WAIT_L(0); PG8_BAR; PG8_MMA(1, 0, At, B0); PG8_MMA(1, 1, At, B1); PG8_BAR; PG8_SCHED;
        }
        if (wr == 0) PG8_BAR;
        if constexpr (FP8) asm volatile("s_nop 15\n\ts_nop 15\n\ts_nop 15\n\ts_nop 15\n\ts_nop 15\n\ts_nop 15\n\ts_nop 15\n\ts_nop 15" ::: "memory");
        const bool keep = E(acc, cur, wr, wc, fr, fq);
        if (!has_next) break;
        if (!keep) {
#pragma unroll
            for (int a = 0; a < 2; ++a)
#pragma unroll
                for (int b = 0; b < 2; ++b)
#pragma unroll
                    for (int m = 0; m < 4; ++m)
#pragma unroll
                        for (int n = 0; n < 2; ++n) acc[a][b][m][n] = (f32x4){0.f, 0.f, 0.f, 0.f};
        }
        cur = nxt; cA = nA; cB = nB; ++ui;
        if (wr == 1) PG8_BAR;
    }
    PG8_WAIT_V(0);
    PG8_BAR;
#undef PG8_SA
#undef PG8_SB
#undef PG8_STAGE
#undef PG8_LDA
#undef PG8_LDB
#undef PG8_MMA
#undef PG8_WAIT_V
#undef PG8_WAIT_L
#undef PG8_BAR
#undef PG8_SCHED
}
}
using pg8::Unit;

template <bool OUT8> struct EpiSwiGLU {
    bf16_t* G; const LAS float* ss; float pre;
    __device__ __forceinline__ bool operator()(f32x4 (&acc)[2][2][4][2], const Unit& u, int wr, int wc, int fr, int fq) const {
        const int row0 = u.pm * 256 + wr * 64 + fr, col0 = u.pn * 128 + wc * 32 + 8 * fq;
        float rsv[2][4];
#pragma unroll
        for (int ai = 0; ai < 2; ++ai)
#pragma unroll
            for (int m = 0; m < 4; ++m) rsv[ai][m] = ss ? ss[ai * 128 + wr * 64 + m * 16 + fr] : 1.f;
#pragma unroll
        for (int ai = 0; ai < 2; ++ai)
#pragma unroll
            for (int m = 0; m < 4; ++m) {
                const int row = row0 + ai * 128 + m * 16;
                const float rs = pre * rsv[ai][m];
                const float c1 = -LOG2E * rs, ik2 = __builtin_amdgcn_rcpf(OUT8 ? rs * rs * G8_SCALE : rs * rs);
                float o[8];
#pragma unroll
                for (int n = 0; n < 2; ++n)
#pragma unroll
                    for (int j = 0; j < 4; j += 2) {
                        const f32x2 A = (f32x2){acc[ai][0][m][n][j], acc[ai][0][m][n][j + 1]}, B = (f32x2){acc[ai][1][m][n][j], acc[ai][1][m][n][j + 1]};
                        const f32x2 t = A * c1; f32x2 e; e.x = __builtin_amdgcn_exp2f(t.x); e.y = __builtin_amdgcn_exp2f(t.y);
                        const f32x2 d = e * ik2 + ik2; f32x2 r; r.x = __builtin_amdgcn_rcpf(d.x); r.y = __builtin_amdgcn_rcpf(d.y);
                        const f32x2 q = (A * B) * r; o[4 * n + j] = q.x; o[4 * n + j + 1] = q.y; }
                if constexpr (OUT8) {
                    unsigned lo = 0u, hi = 0u;
                    lo = __builtin_amdgcn_cvt_pk_fp8_f32(o[0], o[1], lo, false); lo = __builtin_amdgcn_cvt_pk_fp8_f32(o[2], o[3], lo, true);
                    hi = __builtin_amdgcn_cvt_pk_fp8_f32(o[4], o[5], hi, false); hi = __builtin_amdgcn_cvt_pk_fp8_f32(o[6], o[7], hi, true);
                    *(u32x2*)((unsigned char*)G + (size_t)row * DFF + col0) = (u32x2){lo, hi};
                } else {
                    u32x4 w; w.x = cvt_pk_bf16(o[0], o[1]); w.y = cvt_pk_bf16(o[2], o[3]); w.z = cvt_pk_bf16(o[4], o[5]); w.w = cvt_pk_bf16(o[6], o[7]);
                    *(u32x4*)(G + (size_t)row * DFF + col0) = w;
                }
            }
        return false;
    }
};
template <bool RES16, bool OUT32, bool OUT16, bool OUT8, bool SS> struct EpiRes {
    const void* res; float* out; bf16_t* ob; float* ss; unsigned char* ob8; float alpha;
    __device__ __forceinline__ bool operator()(f32x4 (&acc)[2][2][4][2], const Unit& u, int wr, int wc, int fr, int fq) const {
        const int row0 = u.pm * 256 + wr * 64 + fr, col0 = u.pn * 256 + wc * 32 + 8 * fq;
        constexpr int MB = 2;
#pragma unroll
        for (int ai = 0; ai < 2; ++ai)
#pragma unroll
          for (int mb = 0; mb < 4; mb += MB) {
            f32x4 rr[MB][2][2]; u32x4 rh[MB][2];
#pragma unroll
            for (int m = 0; m < MB; ++m) { const size_t off = (size_t)(row0 + ai * 128 + (mb + m) * 16) * DM + col0;
#pragma unroll
                for (int bj = 0; bj < 2; ++bj) {
                    if constexpr (RES16) rh[m][bj] = *(const u32x4*)((const bf16_t*)res + off + bj * 128);
                    else { rr[m][bj][0] = *(const f32x4*)((const float*)res + off + bj * 128); rr[m][bj][1] = *(const f32x4*)((const float*)res + off + bj * 128 + 4); } } }
#pragma unroll
            for (int mm = 0; mm < MB; ++mm) {
                const int m = mb + mm;
                const int row = row0 + ai * 128 + m * 16; const size_t off = (size_t)row * DM + col0; float sq = 0.f;
#pragma unroll
                for (int bj = 0; bj < 2; ++bj) {
                    f32x4 r0, r1;
                    if constexpr (RES16) { const u32x4 h = rh[mm][bj]; r0 = (f32x4){bf_lo(h.x), bf_hi(h.x), bf_lo(h.y), bf_hi(h.y)}; r1 = (f32x4){bf_lo(h.z), bf_hi(h.z), bf_lo(h.w), bf_hi(h.w)}; }
                    else { r0 = rr[mm][bj][0]; r1 = rr[mm][bj][1]; }
                    const f32x4 o0 = r0 + acc[ai][bj][m][0] * alpha, o1 = r1 + acc[ai][bj][m][1] * alpha;
                    if constexpr (OUT32) { *(f32x4*)(out + off + bj * 128) = o0; *(f32x4*)(out + off + bj * 128 + 4) = o1; }
                    if constexpr (OUT16) { u32x4 w; w.x = cvt_pk_bf16(o0[0], o0[1]); w.y = cvt_pk_bf16(o0[2], o0[3]); w.z = cvt_pk_bf16(o1[0], o1[1]); w.w = cvt_pk_bf16(o1[2], o1[3]);
                        *(u32x4*)(ob + off + bj * 128) = w; }
                    if constexpr (SS) sq += (o0[0] * o0[0] + o0[1] * o0[1]) + (o0[2] * o0[2] + o0[3] * o0[3]) + (o1[0] * o1[0] + o1[1] * o1[1]) + (o1[2] * o1[2] + o1[3] * o1[3]);
                    if constexpr (OUT8) {
                        unsigned lo = 0u, hi = 0u;
                        lo = __builtin_amdgcn_cvt_pk_fp8_f32(o0[0] * H8_SCALE, o0[1] * H8_SCALE, lo, false); lo = __builtin_amdgcn_cvt_pk_fp8_f32(o0[2] * H8_SCALE, o0[3] * H8_SCALE, lo, true);
                        hi = __builtin_amdgcn_cvt_pk_fp8_f32(o1[0] * H8_SCALE, o1[1] * H8_SCALE, hi, false); hi = __builtin_amdgcn_cvt_pk_fp8_f32(o1[2] * H8_SCALE, o1[3] * H8_SCALE, hi, true);
                        *(u32x2*)(ob8 + off + bj * 128) = (u32x2){lo, hi};
                    }
                }
                if constexpr (SS) { sq += __shfl_xor(sq, 16); sq += __shfl_xor(sq, 32); if (fq == 0) ss[(size_t)row * 64 + u.pn * 4 + wc] = sq; }
            }
          }
        return false;
    }
};
template <int PART> struct EpiIn {
    const LAS float* rsl; bf16_t* U; bf16_t* V; bf16_t* Qr; bf16_t* QIr; float* KVr; unsigned char* gates; const float* gbias; float* ssv;
    __device__ __forceinline__ bool operator()(f32x4 (&acc)[2][2][4][2], const Unit& u, int wr, int wc, int fr, int fq) const {
        const int row0 = u.pm * 256 + wr * 64 + fr, c8 = wc * 32 + 8 * fq; const int pp = u.pn;
        const int pn = PART == 0 ? (pp < 16 ? pp : pp < 24 ? pp + 8 : pp + 8) : (pp < 8 ? 16 + pp : pp + 42);
        float rsv[2][4];
#pragma unroll
        for (int ai = 0; ai < 2; ++ai)
#pragma unroll
            for (int m = 0; m < 4; ++m) rsv[ai][m] = rsl[ai * 128 + wr * 64 + m * 16 + fr];
        f32x4 gbv[2][2];
        if (pn >= 34) { const int gc = (pn - 34) * 256 + c8;
#pragma unroll
            for (int bj = 0; bj < 2; ++bj) { gbv[bj][0] = *(const f32x4*)(gbias + gc + bj * 128) * (-LOG2E); gbv[bj][1] = *(const f32x4*)(gbias + gc + bj * 128 + 4) * (-LOG2E); } }
        else {
#pragma unroll
            for (int bj = 0; bj < 2; ++bj) { gbv[bj][0] = (f32x4){0.f, 0.f, 0.f, 0.f}; gbv[bj][1] = (f32x4){0.f, 0.f, 0.f, 0.f}; } }
#pragma unroll
        for (int ai = 0; ai < 2; ++ai)
#pragma unroll
            for (int m = 0; m < 4; ++m) {
                const int row = row0 + ai * 128 + m * 16;
                const float rs = (PART == 0 ? 1.0f : 1.0f / (H8_SCALE * WIN8_SCALE)) * rsv[ai][m];
                const float c1 = -LOG2E * rs;
                f32x4 v[2][2];
#pragma unroll
                for (int bj = 0; bj < 2; ++bj)
#pragma unroll
                    for (int n = 0; n < 2; ++n) v[bj][n] = acc[ai][bj][m][n] * rs;
                if (pn < 16) {
                    bf16_t* dst = (pn < 8 ? U : V) + (size_t)row * GW + (pn & 7) * 256 + c8; float sq = 0.f;
#pragma unroll
                    for (int bj = 0; bj < 2; ++bj) {
                        const f32x4 g0 = gelu4(v[bj][0]), g1 = gelu4(v[bj][1]);
                        u32x4 w; w.x = cvt_pk_bf16(g0[0], g0[1]); w.y = cvt_pk_bf16(g0[2], g0[3]); w.z = cvt_pk_bf16(g1[0], g1[1]); w.w = cvt_pk_bf16(g1[2], g1[3]);
                        *(u32x4*)(dst + bj * 128) = w;
                        sq += (g0[0] * g0[0] + g0[1] * g0[1]) + (g0[2] * g0[2] + g0[3] * g0[3]) + (g1[0] * g1[0] + g1[1] * g1[1]) + (g1[2] * g1[2] + g1[3] * g1[3]);
                    }
                    if (pn >= 8) { sq += __shfl_xor(sq, 16); sq += __shfl_xor(sq, 32); if (fq == 0) ssv[(size_t)row * 32 + (pn - 8) * 4 + wc] = sq; }
                } else if (pn < 32) {
                    bf16_t* dst = (pn < 24 ? Qr : QIr) + (size_t)row * 2048 + (pn & 7) * 256 + c8;
#pragma unroll
                    for (int bj = 0; bj < 2; ++bj) {
                        u32x4 w; w.x = cvt_pk_bf16(v[bj][0][0], v[bj][0][1]); w.y = cvt_pk_bf16(v[bj][0][2], v[bj][0][3]); w.z = cvt_pk_bf16(v[bj][1][0], v[bj][1][1]); w.w = cvt_pk_bf16(v[bj][1][2], v[bj][1][3]);
                        *(u32x4*)(dst + bj * 128) = w;
                    }
                } else if (pn < 34) {
                    float* dst = KVr + (size_t)row * KVW + (pn - 32) * 256 + c8;
#pragma unroll
                    for (int bj = 0; bj < 2; ++bj)
                        if (pn == 32 || (bj == 0 && wc < 3)) { *(f32x4*)(dst + bj * 128) = v[bj][0]; *(f32x4*)(dst + bj * 128 + 4) = v[bj][1]; }
                } else {
                    unsigned char* dst = gates + (size_t)row * NGATE + (pn - 34) * 256 + c8;
#pragma unroll
                    for (int bj = 0; bj < 2; ++bj) {
                        unsigned q[8];
#pragma unroll
                        for (int j = 0; j < 4; ++j) {
                            constexpr float IC = 1.0f / 255.996f;
                            const float g0 = __builtin_amdgcn_rcpf(__builtin_amdgcn_exp2f(acc[ai][bj][m][0][j] * c1 + gbv[bj][0][j]) * IC + IC);
                            const float g1 = __builtin_amdgcn_rcpf(__builtin_amdgcn_exp2f(acc[ai][bj][m][1][j] * c1 + gbv[bj][1][j]) * IC + IC);
                            q[j] = (unsigned)g0; q[4 + j] = (unsigned)g1; }
                        const u32x2 w = (u32x2){q[0] | (q[1] << 8) | (q[2] << 16) | (q[3] << 24), q[4] | (q[5] << 8) | (q[6] << 16) | (q[7] << 24)};
                        *(u32x2*)(dst + bj * 128) = w;
                    }
                }
            }
        return false;
    }
};
struct EpiMerge {
    const unsigned char* gates; bf16_t* Mb;
    __device__ __forceinline__ bool operator()(f32x4 (&acc)[2][2][4][2], const Unit& u, int wr, int wc, int fr, int fq) const {
        const int row0 = u.pm * 256 + wr * 64 + fr, col0 = u.pn * 256 + wc * 32 + 8 * fq;
#pragma unroll
        for (int ai = 0; ai < 2; ++ai) {
            u32x2 gbr[4][2], gar[4][2];
#pragma unroll
            for (int m = 0; m < 4; ++m)
#pragma unroll
                for (int bj = 0; bj < 2; ++bj) { const unsigned char* gp = gates + (size_t)(row0 + ai * 128 + m * 16) * NGATE + col0 + bj * 128;
                    gbr[m][bj] = *(const u32x2*)(gp + DM); gar[m][bj] = (u.seg == 0) ? *(const u32x2*)gp : (u32x2){0u, 0u}; }
#pragma unroll
            for (int m = 0; m < 4; ++m) {
                const int row = row0 + ai * 128 + m * 16;
#pragma unroll
                for (int bj = 0; bj < 2; ++bj) {
                    const int col = col0 + bj * 128;
                    const u32x2 gb = gbr[m][bj];
                    float fb[8];
#pragma unroll
                    for (int j = 0; j < 4; ++j) { fb[j] = (float)((gb.x >> (8 * j)) & 255u) + 0.5f; fb[4 + j] = (float)((gb.y >> (8 * j)) & 255u) + 0.5f; }
                    if (u.seg == 0) {
                        const u32x2 ga = gar[m][bj];
#pragma unroll
                        for (int j = 0; j < 4; ++j) {
                            const float a0 = (float)((ga.x >> (8 * j)) & 255u) + 0.5f, a1 = (float)((ga.y >> (8 * j)) & 255u) + 0.5f;
                            acc[ai][bj][m][0][j] *= a0 * __builtin_amdgcn_rcpf(fb[j]); acc[ai][bj][m][1][j] *= a1 * __builtin_amdgcn_rcpf(fb[4 + j]); }
                    } else {
                        float o[8];
#pragma unroll
                        for (int j = 0; j < 4; ++j) { o[j] = acc[ai][bj][m][0][j] * (fb[j] * (1.0f / 256.0f)); o[4 + j] = acc[ai][bj][m][1][j] * (fb[4 + j] * (1.0f / 256.0f)); }
                        u32x4 w; w.x = cvt_pk_bf16(o[0], o[1]); w.y = cvt_pk_bf16(o[2], o[3]); w.z = cvt_pk_bf16(o[4], o[5]); w.w = cvt_pk_bf16(o[6], o[7]);
                        *(u32x4*)(Mb + (size_t)row * DM + col) = w;
                    }
                }
            }
        }
        return u.seg == 0;
    }
};

struct Params { const float* in[21]; float* out; unsigned char* ws; int ph_lo, ph_hi; };
enum In { I_X = 0, I_F1N, I_F1W1, I_F1W3, I_F1W2, I_MIXN, I_WIN, I_GBIAS, I_VNORM, I_GWS, I_GBS, I_QN, I_KN, I_IKN, I_WBA, I_WBB, I_WOUT, I_F2N, I_F2W1, I_F2W3, I_F2W2 };

struct ConvD { const float* src; const float* gain; unsigned char* dst; int N; int pitch; int mode; float sc; };
__device__ __forceinline__ ConvD conv_desc(const Params& p, int it) {
    unsigned char* ws = p.ws; ConvD d; d.gain = nullptr; d.sc = 1.0f; d.mode = 1;
    constexpr int I_W13 = (DM / 64) * (2 * DFF / 32), I_W2 = (DFF / 64) * (DM / 32), I_WINI = (DM / 64) * (NIN / 32), I_WAB = (GW / 64) * (DM / 32);
    int r = it;
    if (r < 2 * I_W13) {
        const int second = r >= I_W13; if (second) r -= I_W13;
        constexpr int nrb = 2 * DFF / 32; const int kb = r / nrb, rb = r % nrb, r0 = 32 * rb, pn = r0 >> 8, rr = r0 & 255, k0 = 64 * kb;
        const float* w = second ? (rr < 128 ? p.in[I_F2W1] : p.in[I_F2W3]) : (rr < 128 ? p.in[I_F1W1] : p.in[I_F1W3]);
        d.src = w + (size_t)k0 * DFF + 128 * pn + (rr & 127); d.N = DFF; d.gain = (second ? p.in[I_F2N] : p.in[I_F1N]) + k0;
        if (second && USE_FP8_UP2) { d.mode = 3; d.sc = WIN8_SCALE; d.dst = ws + WS_W13B + (size_t)r0 * DM + k0; d.pitch = DM; return d; }
        d.dst = ws + (second ? WS_W13B : WS_W13A) + ((size_t)r0 * DM + k0) * 2; d.pitch = DM * 2; return d;
    }
    r -= 2 * I_W13;
    if (r < 2 * I_W2) {
        const int second = r >= I_W2; if (second) r -= I_W2;
        constexpr int nrb = DM / 32; const int kb = r / nrb, rb = r % nrb, r0 = 32 * rb, k0 = 64 * kb;
        d.src = (second ? p.in[I_F2W2] : p.in[I_F1W2]) + (size_t)k0 * DM + r0; d.N = DM;
        if (second ? (USE_FP8_DOWN != 0) : (USE_FP8_DOWN1 != 0)) { d.mode = 2; d.sc = W8_SCALE; d.dst = ws + (second ? WS_W2B : WS_W2A) + (size_t)r0 * DFF + k0; d.pitch = DFF; }
        else { d.dst = ws + (second ? WS_W2B : WS_W2A) + ((size_t)r0 * DFF + k0) * 2; d.pitch = DFF * 2; }
        return d;
    }
    r -= 2 * I_W2;
    if (r < I_WINI) {
        constexpr int nrbA = NIN_A / 32, I_A = (DM / 64) * nrbA, nrbB = NIN_B / 32;
        const bool partB = r >= I_A; if (partB) r -= I_A;
        const int nrb = partB ? nrbB : nrbA, kb = r / nrb, rb = r % nrb, r0 = 32 * rb, k0 = 64 * kb, pt = r0 >> 8, w = r0 & 255;
        int n0;
        if (!partB) n0 = pt < 16 ? r0 : pt < 24 ? 6400 + (r0 - 4096) : pt == 24 ? 6144 + w : pt == 25 ? (w < 96 ? 8448 + w : -1) : 8544 + (pt - 26) * 256 + w;
        else        n0 = pt < 8 ? 4096 + r0 : 12640 + (pt - 8) * 256 + w;
        d.src = p.in[I_WIN] + (size_t)k0 * 16736 + (n0 < 0 ? 0 : n0); d.N = 16736; d.gain = p.in[I_MIXN] + k0; if (n0 < 0) d.mode = 0;
        if (partB) { d.mode = 3; d.sc = WIN8_SCALE; d.dst = ws + WS_WINB8 + (size_t)r0 * DM + k0; d.pitch = DM; }
        else { d.dst = ws + WS_WIN + ((size_t)r0 * DM + k0) * 2; d.pitch = DM * 2; }
        return d;
    }
    r -= I_WINI;
    if (r < 2 * I_WAB) {
        const int second = r >= I_WAB; if (second) r -= I_WAB;
        constexpr int nrb = DM / 32; const int kb = r / nrb, rb = r % nrb, r0 = 32 * rb, k0 = 64 * kb;
        d.src = (second ? p.in[I_WBB] : p.in[I_WBA]) + (size_t)k0 * DM + r0; d.N = DM;
        d.dst = ws + (second ? WS_WB : WS_WA) + ((size_t)r0 * GW + k0) * 2; d.pitch = GW * 2; return d;
    }
    r -= 2 * I_WAB;
    { constexpr int nrb = DM / 32; const int kb = r / nrb, rb = r % nrb, r0 = 32 * rb, k0 = 64 * kb;
      d.src = p.in[I_WOUT] + (size_t)k0 * DM + r0; d.N = DM; d.dst = ws + WS_WOUT + ((size_t)r0 * DM + k0) * 2; d.pitch = DM * 2; return d; }
}
__device__ __forceinline__ void conv_load(const ConvD& d, f32x4 (&v)[8], int lane) {
    if (d.mode == 0) return;
#pragma unroll
    for (int i = 0; i < 8; ++i) v[i] = *(const f32x4*)(d.src + (size_t)(8 * i + (lane >> 3)) * d.N + 4 * (lane & 7));
}
__device__ __forceinline__ void conv_finish(const ConvD& d, const f32x4 (&v)[8], LAS float* scr, int lane) {
    if (d.mode == 0) {
#pragma unroll
        for (int j = 0; j < 4; ++j) { const int q = lane + 64 * j; *(u32x4*)(d.dst + (size_t)(q >> 3) * d.pitch + 16 * (q & 7)) = (u32x4){0u, 0u, 0u, 0u}; }
        return;
    }
#pragma unroll
    for (int i = 0; i < 8; ++i) { const int kk = 8 * i + (lane >> 3); const float gn = d.gain ? d.gain[kk] * d.sc : d.sc; LAS float* s = scr + kk * 33 + 4 * (lane & 7);
        s[0] = v[i][0] * gn; s[1] = v[i][1] * gn; s[2] = v[i][2] * gn; s[3] = v[i][3] * gn; }
    asm volatile("s_waitcnt lgkmcnt(0)" ::: "memory");
    const int c = lane & 7;
#pragma unroll
    for (int j = 0; j < 4; ++j) { const int n = (lane >> 3) + 8 * j; const LAS float* s = scr + (8 * c) * 33 + n;
        if (d.mode >= 2) {
            unsigned lo = 0u, hi = 0u;
            lo = __builtin_amdgcn_cvt_pk_fp8_f32(s[0 * 33], s[1 * 33], lo, false); lo = __builtin_amdgcn_cvt_pk_fp8_f32(s[2 * 33], s[3 * 33], lo, true);
            hi = __builtin_amdgcn_cvt_pk_fp8_f32(s[4 * 33], s[5 * 33], hi, false); hi = __builtin_amdgcn_cvt_pk_fp8_f32(s[6 * 33], s[7 * 33], hi, true);
            *(u32x2*)(d.dst + (size_t)n * d.pitch + 8 * c) = (u32x2){lo, hi};
        } else {
            u32x4 o; o.x = cvt_pk_bf16(s[0 * 33], s[1 * 33]); o.y = cvt_pk_bf16(s[2 * 33], s[3 * 33]); o.z = cvt_pk_bf16(s[4 * 33], s[5 * 33]); o.w = cvt_pk_bf16(s[6 * 33], s[7 * 33]);
            *(u32x4*)(d.dst + (size_t)n * d.pitch + 16 * c) = o;
        } }
    asm volatile("s_waitcnt lgkmcnt(0)" ::: "memory");
}
__device__ __forceinline__ void conv_items(const Params& p, LAS float* scr, int first, int stride, int count, int skip_at, int skip_n, int lane, int skip2_at = 0x7fffffff, int skip2_n = 0) {
    if (first >= count) return;
    auto idx = [&](int i) { const int j = i < skip_at ? i : i + skip_n; return j < skip2_at ? j : j + skip2_n; };
    ConvD d = conv_desc(p, idx(first)); f32x4 v[8]; conv_load(d, v, lane);
    for (int it = first; it < count; it += stride) {
        const bool has = it + stride < count; ConvD dn = d; f32x4 vn[8];
        if (has) { dn = conv_desc(p, idx(it + stride)); conv_load(dn, vn, lane); }
        conv_finish(d, v, scr, lane);
        if (has) { d = dn;
#pragma unroll
            for (int i = 0; i < 8; ++i) v[i] = vn[i]; }
    }
}
__device__ __forceinline__ void phase_prologue(const Params& p, LAS unsigned char* lds, int tid, int lane, int wave) {
    unsigned char* ws = p.ws;
    const int gw = (int)blockIdx.x * 8 + wave, NGW = (int)gridDim.x * 8;
    LAS float* scr = (LAS float*)(lds + wave * 16384);
    constexpr int I_W13 = (DM / 64) * (2 * DFF / 32), I_W2 = (DFF / 64) * (DM / 32), I_WINI = (DM / 64) * (NIN / 32), I_WAB = (GW / 64) * (DM / 32), I_WO = (DM / 64) * (DM / 32);
    constexpr int NITEMS = 2 * I_W13 + 2 * I_W2 + I_WINI + 2 * I_WAB + I_WO;
    conv_items(p, scr, gw, NGW, NITEMS - I_W2 - I_W2 / 2, 2 * I_W13, I_W2, lane, 2 * I_W13 + I_W2 + I_W2 / 2, I_W2 / 2);
    { const float* x = p.in[I_X]; bf16_t* xb = (bf16_t*)(ws + WS_R1);
      for (int row = gw; row < MROWS; row += NGW) {
          const f32x4* xr = (const f32x4*)(x + (size_t)row * DM) + lane; f32x4 v[16]; float s = 0.f;
#pragma unroll
          for (int j = 0; j < 16; ++j) { v[j] = xr[64 * j]; s += (v[j][0] * v[j][0] + v[j][1] * v[j][1]) + (v[j][2] * v[j][2] + v[j][3] * v[j][3]); }
          const float rs = 1.0f / sqrtf(wave_sum(s) * (1.0f / DM) + EPS);
          u32x2* o = (u32x2*)(xb + (size_t)row * DM) + lane;
#pragma unroll
          for (int j = 0; j < 16; ++j) { u32x2 w; w.x = cvt_pk_bf16(v[j][0] * rs, v[j][1] * rs); w.y = cvt_pk_bf16(v[j][2] * rs, v[j][3] * rs); o[64 * j] = w; }
      } }
    { const int gt = (int)blockIdx.x * 512 + tid, NT = (int)gridDim.x * 512;
      float* cosA = (float*)(ws + WS_COSA); float* sinA = (float*)(ws + WS_SINA); float* cosI = (float*)(ws + WS_COSI); float* sinI = (float*)(ws + WS_SINI);
      for (int i = gt; i < SEQ * 64; i += NT) { const int pos = i >> 6, f = i & 63; const float inv = powf(10000.0f, -(float)(2 * f) / 128.0f); const float ang = (float)pos * inv; cosA[i] = cosf(ang); sinA[i] = sinf(ang); }
      for (int i = gt; i < SEQ * 32; i += NT) { const int pos = i >> 5, f = i & 31; const float inv = powf(10000.0f, -(float)(2 * f) / 64.0f); const float ang = (float)pos * inv; cosI[i] = cosf(ang); sinI[i] = sinf(ang); }
      bf16_t* w16 = (bf16_t*)(ws + WS_WS16); const float* gws = p.in[I_GWS];
      for (int i = gt; i < 16 * 128 * 128 / 2; i += NT) { const int e = 2 * i, t = (e >> 7) & 127, s = e & 127; const float a = gws[e], b = gws[e + 1]; const bool z = (t < 64 && s >= 64);
          ((unsigned*)w16)[i] = z ? 0u : cvt_pk_bf16(a, b); }
    }
}

__device__ __forceinline__ void panel_rs(const float* ssp, int pm, LAS float* rsl, int tid) {
    const int r = tid >> 1, hf = tid & 1; const f32x4* pp = (const f32x4*)(ssp + (size_t)(pm * 256 + r) * 64 + hf * 32);
    f32x4 a[8];
#pragma unroll
    for (int i = 0; i < 8; ++i) a[i] = pp[i];
    float s = 0.f;
#pragma unroll
    for (int i = 0; i < 8; ++i) s += (a[i][0] + a[i][1]) + (a[i][2] + a[i][3]);
    s += __shfl_xor(s, 1);
    if (hf == 0) rsl[r] = 1.0f / sqrtf(s * (1.0f / DM) + EPS);
    __syncthreads();
}
__device__ __forceinline__ void phase_post(const Params& p, int lane, int wave) {
    unsigned char* ws = p.ws;
    const int gw = (int)blockIdx.x * 8 + wave, NGW = (int)gridDim.x * 8;
    const float* KVr = (const float*)(ws + WS_KVR); bf16_t* Kn = (bf16_t*)(ws + WS_KN); bf16_t* Vb = (bf16_t*)(ws + WS_VB); bf16_t* KIn = (bf16_t*)(ws + WS_KIN); float* WI = (float*)(ws + WS_WI);
    const float* cosA = (const float*)(ws + WS_COSA); const float* sinA = (const float*)(ws + WS_SINA); const float* cosI = (const float*)(ws + WS_COSI); const float* sinI = (const float*)(ws + WS_SINI);
    const float* kn = p.in[I_KN]; const float* ikn = p.in[I_IKN];
    const float g1 = kn[lane], g2 = kn[64 + lane]; const float ig1 = ikn[lane & 31], ig2 = ikn[32 + (lane & 31)];
    const float* ssvp = (const float*)(ws + WS_SSVP); float* ssvo = (float*)(ws + CTL_SSV);
    for (int row = gw; row < MROWS; row += NGW) {
        { const float pv = wave_sum(lane < 32 ? ssvp[(size_t)row * 32 + lane] : 0.f); if (lane == 0) ssvo[row] = pv; }
        const float* kv = KVr + (size_t)row * KVW; const int pos = row & (SEQ - 1);
        { const float x1 = kv[lane], x2 = kv[64 + lane]; const float rs = 1.0f / sqrtf(wave_sum(x1 * x1 + x2 * x2) * (1.0f / 128.0f) + EPS);
          const float y1 = x1 * rs * g1, y2 = x2 * rs * g2, c = cosA[pos * 64 + lane], s = sinA[pos * 64 + lane];
          Kn[(size_t)row * 128 + lane] = (bf16_t)(cvt_pk_bf16(y1 * c - y2 * s, 0.f) & 0xffffu); Kn[(size_t)row * 128 + 64 + lane] = (bf16_t)(cvt_pk_bf16(y1 * s + y2 * c, 0.f) & 0xffffu); }
        { const float a = kv[128 + 2 * lane], b = kv[129 + 2 * lane]; ((unsigned*)(Vb + (size_t)row * 128))[lane] = cvt_pk_bf16(a, b); }
        { const int l = lane & 31; const float x1 = kv[256 + l], x2 = kv[288 + l]; const float rs = 1.0f / sqrtf(wave_sum(lane < 32 ? x1 * x1 + x2 * x2 : 0.f) * (1.0f / 64.0f) + EPS);
          const float y1 = x1 * rs * ig1, y2 = x2 * rs * ig2, c = cosI[pos * 32 + l], s = sinI[pos * 32 + l];
          if (lane < 32) { KIn[(size_t)row * 64 + l] = (bf16_t)(cvt_pk_bf16(y1 * c - y2 * s, 0.f) & 0xffffu); KIn[(size_t)row * 64 + 32 + l] = (bf16_t)(cvt_pk_bf16(y1 * s + y2 * c, 0.f) & 0xffffu);
                           WI[(size_t)row * 32 + l] = kv[320 + l] * IDX_SCALE; } }
    }
}

typedef short s16x4 __attribute__((ext_vector_type(4)));
constexpr int VROW = 288;
struct GmlpSet { u32x4 raw[4]; float ssn[4]; u32x2 ur[8]; };
__device__ __forceinline__ void gmlp_units(const Params& p, LAS unsigned char* lds, int G, int tid, int lane, int wave) {
    unsigned char* ws = p.ws;
    const bf16_t* Vg = (const bf16_t*)(ws + WS_V); const bf16_t* U = (const bf16_t*)(ws + WS_U); bf16_t* Ya = (bf16_t*)(ws + WS_YA);
    const float* ssv = (const float*)(ws + CTL_SSV);
    const int n = lane & 15, g4 = lane >> 4, tl = 16 * wave + n;
    const int u0 = (int)blockIdx.x;
    if (u0 >= 2048) return;
    const int nun = (2048 - u0 + G - 1) / G, ulast = u0 + (nun - 1) * G;
    const int srow = tid >> 4, scc = tid & 15;
    const unsigned stoff = (unsigned)(srow * VROW + scc * 16), tboff = (unsigned)((4 * g4 + (n >> 2)) * VROW + 8 * (n & 3));
    GmlpSet S0, S1;
    bf16x8 bw[4]; f32x4 gnv[8]; float bsv; int gcur = -1;
#define GM_LOAD_V(S, un) do { const int un_ = (un) < ulast ? (un) : ulast; const int r0_ = (un_ >> 4) * 128, c0_ = (un_ & 15) * 128; \
        _Pragma("unroll") for (int i = 0; i < 4; ++i) { S.raw[i] = *(const u32x4*)(Vg + (size_t)(r0_ + srow + 32 * i) * GW + c0_ + 8 * scc); S.ssn[i] = ssv[r0_ + srow + 32 * i]; } } while (0)
#define GM_LOAD_U(S, un) do { const int un_ = (un) < ulast ? (un) : ulast; const int r0_ = (un_ >> 4) * 128, c0_ = (un_ & 15) * 128; \
        _Pragma("unroll") for (int tn = 0; tn < 8; ++tn) S.ur[tn] = *(const u32x2*)(U + (size_t)(r0_ + tl) * GW + c0_ + 16 * tn + 4 * g4); } while (0)
#define GM_BODY(S, tileoff, unit) do { \
        const int g = (unit) & 15, r0 = ((unit) >> 4) * 128, c0 = g * 128; \
        LAS unsigned char* tile = lds + (tileoff); \
        _Pragma("unroll") for (int i = 0; i < 4; ++i) { \
            const float rs = __builtin_amdgcn_rsqf(S.ssn[i] * (1.0f / GW) + EPS); \
            const unsigned wv_[4] = {S.raw[i].x, S.raw[i].y, S.raw[i].z, S.raw[i].w}; u32x4 o_; \
            o_.x = cvt_pk_bf16(bf_lo(wv_[0]) * rs, bf_hi(wv_[0]) * rs); o_.y = cvt_pk_bf16(bf_lo(wv_[1]) * rs, bf_hi(wv_[1]) * rs); \
            o_.z = cvt_pk_bf16(bf_lo(wv_[2]) * rs, bf_hi(wv_[2]) * rs); o_.w = cvt_pk_bf16(bf_lo(wv_[3]) * rs, bf_hi(wv_[3]) * rs); \
            *(LAS u32x4*)(tile + stoff + i * 32 * VROW) = o_; } \
        __syncthreads(); \
        GM_LOAD_V(S, (unit) + 2 * G); \
        if (g != gcur) { gcur = g; const bf16_t* w16 = (const bf16_t*)(ws + WS_WS16) + (size_t)g * 128 * 128 + (size_t)tl * 128 + 4 * g4; \
            _Pragma("unroll") for (int ks = 0; ks < 4; ++ks) { const u32x2 lo_ = *(const u32x2*)(w16 + 32 * ks), hi_ = *(const u32x2*)(w16 + 32 * ks + 16); \
                const u32x4 w_ = (u32x4){lo_.x, lo_.y, hi_.x, hi_.y}; bw[ks] = __builtin_bit_cast(bf16x8, w_); } \
            bsv = p.in[I_GBS][g * 128 + tl]; \
            _Pragma("unroll") for (int tn = 0; tn < 8; ++tn) gnv[tn] = *(const f32x4*)(p.in[I_VNORM] + c0 + 16 * tn + 4 * g4); } \
        const size_t rowoff = (size_t)(r0 + tl) * GW + c0; \
        _Pragma("unroll") for (int tn = 0; tn < 8; ++tn) { \
            f32x4 acc = (f32x4){0.f, 0.f, 0.f, 0.f}; \
            _Pragma("unroll") for (int ks = 0; ks < 4; ++ks) { \
                const s16x4 t0_ = __builtin_amdgcn_ds_read_tr16_b64_v4i16((LAS s16x4*)(tile + tboff + ks * 32 * VROW + tn * 32)); \
                const s16x4 t1_ = __builtin_amdgcn_ds_read_tr16_b64_v4i16((LAS s16x4*)(tile + tboff + ks * 32 * VROW + 16 * VROW + tn * 32)); \
                const bf16x8 av = (bf16x8){t0_[0], t0_[1], t0_[2], t0_[3], t1_[0], t1_[1], t1_[2], t1_[3]}; \
                acc = __builtin_amdgcn_mfma_f32_16x16x32_bf16(av, bw[ks], acc, 0, 0, 0); } \
            const int cl = 16 * tn + 4 * g4;                                     \
            const f32x4 gn = gnv[tn]; \
            const float uu[4] = {bf_lo(S.ur[tn].x), bf_hi(S.ur[tn].x), bf_lo(S.ur[tn].y), bf_hi(S.ur[tn].y)}; float o[4]; \
            _Pragma("unroll") for (int r = 0; r < 4; ++r) o[r] = uu[r] * (acc[r] * gn[r] + bsv); \
            u32x2 w; w.x = cvt_pk_bf16(o[0], o[1]); w.y = cvt_pk_bf16(o[2], o[3]); \
            *(u32x2*)(Ya + rowoff + cl) = w; } \
        GM_LOAD_U(S, (unit) + 2 * G); } while (0)
    GM_LOAD_V(S0, u0); GM_LOAD_U(S0, u0); GM_LOAD_V(S1, u0 + G); GM_LOAD_U(S1, u0 + G);
    for (int unit = u0; unit <= ulast; unit += 2 * G) {
        GM_BODY(S0, 0, unit);
        if (unit + G <= ulast) GM_BODY(S1, 128 * VROW, unit + G);
    }
    __syncthreads();
#undef GM_LOAD_V
#undef GM_LOAD_U
#undef GM_BODY
}

constexpr int VCH = 32 * VROW;
static_assert(8 * 2 * VCH <= LDS_SEL, "V chunk buffers overlay the score rows and the key stage, not the selection lists");
__device__ __forceinline__ unsigned sortable_key(float s) { const unsigned b = __float_as_uint(s); return b ^ (((unsigned)((int)b >> 31)) | 0x80000000u); }
__device__ __forceinline__ void dsa_unit(const Params& p, LAS unsigned char* lds, int b, int c8, int tid, int lane, int wave) {
    unsigned char* ws = p.ws;
    const int t0 = c8 * 8, kend = 64 * ((t0 >> 6) + 1), tok = t0 + wave; const size_t row = (size_t)b * SEQ + tok;
    LAS unsigned* sc = (LAS unsigned*)(lds + LDS_SC) + wave * 4096;
    LAS unsigned short* sel = (LAS unsigned short*)(lds + LDS_SEL) + wave * 256;
    int nsel = 0;
    if (kend <= 256) {
        nsel = kend;
#pragma unroll
        for (int i = 0; i < 4; ++i) sel[lane + 64 * i] = (unsigned short)(lane + 64 * i);
    } else {
        nsel = 256;
        bf16x8 qa[4]; float wv[16];
        { const bf16_t* qp = (const bf16_t*)(ws + WS_QIR) + row * 2048 + (lane & 31) * 64 + 8 * (lane >> 5);
          u32x4 raw[4];
#pragma unroll
          for (int ks = 0; ks < 4; ++ks) raw[ks] = *(const u32x4*)(qp + 16 * ks);
          const float* cp = (const float*)(ws + WS_COSI) + tok * 32 + 8 * (lane >> 5); const float* sp = (const float*)(ws + WS_SINI) + tok * 32 + 8 * (lane >> 5);
#pragma unroll
          for (int ks = 0; ks < 2; ++ks) {
              const f32x4 c0 = *(const f32x4*)(cp + 16 * ks), c1 = *(const f32x4*)(cp + 16 * ks + 4), s0 = *(const f32x4*)(sp + 16 * ks), s1 = *(const f32x4*)(sp + 16 * ks + 4);
              const float cc[8] = {c0[0], c0[1], c0[2], c0[3], c1[0], c1[1], c1[2], c1[3]}, ss[8] = {s0[0], s0[1], s0[2], s0[3], s1[0], s1[1], s1[2], s1[3]};
              const unsigned w1[4] = {raw[ks].x, raw[ks].y, raw[ks].z, raw[ks].w}, w2[4] = {raw[ks + 2].x, raw[ks + 2].y, raw[ks + 2].z, raw[ks + 2].w};
              unsigned o1[4], o2[4];
#pragma unroll
              for (int e = 0; e < 4; ++e) {
                  const float a0 = bf_lo(w1[e]), a1 = bf_hi(w1[e]), b0 = bf_lo(w2[e]), b1 = bf_hi(w2[e]);
                  o1[e] = cvt_pk_bf16(a0 * cc[2 * e] - b0 * ss[2 * e], a1 * cc[2 * e + 1] - b1 * ss[2 * e + 1]);
                  o2[e] = cvt_pk_bf16(a0 * ss[2 * e] + b0 * cc[2 * e], a1 * ss[2 * e + 1] + b1 * cc[2 * e + 1]);
              }
              const u32x4 p1 = (u32x4){o1[0], o1[1], o1[2], o1[3]}, p2 = (u32x4){o2[0], o2[1], o2[2], o2[3]};
              qa[ks] = __builtin_bit_cast(bf16x8, p1); qa[ks + 2] = __builtin_bit_cast(bf16x8, p2);
          }
          const float* wp = (const float*)(ws + WS_WI) + row * 32 + 4 * (lane >> 5);
#pragma unroll
          for (int q = 0; q < 4; ++q) { const f32x4 t = *(const f32x4*)(wp + 8 * q); wv[4 * q] = t[0]; wv[4 * q + 1] = t[1]; wv[4 * q + 2] = t[2]; wv[4 * q + 3] = t[3]; }
        }
        const bf16_t* kbase = (const bf16_t*)(ws + WS_KIN) + (size_t)b * SEQ * 64;
        const int nst = kend >> 6; const int skey = tid >> 3, sch = tid & 7;
        const int lastst = nst - 1, nst4 = (nst + 3) & ~3;
        const unsigned wroff = (unsigned)(LDS_KST + skey * KPITCH + sch * 16);
        const int key0 = lane & 31, h5 = lane >> 5;
        const unsigned rdoff = (unsigned)(LDS_KST + key0 * KPITCH + h5 * 16);
        unsigned rb0 = rdoff, rb1 = rdoff + KSTG, rb2 = rdoff + 2 * KSTG;
        unsigned wb0 = wroff + 2 * KSTG, wb1 = wroff, wb2 = wroff + KSTG;
        { const u32x4 v0 = *(const u32x4*)(kbase + tid * 8), v1 = *(const u32x4*)(kbase + (size_t)(1 < lastst ? 1 : lastst) * 4096 + tid * 8);
          *(LAS u32x4*)(lds + wroff) = v0; *(LAS u32x4*)(lds + wroff + KSTG) = v1; }
        u32x4 pre[4];
#pragma unroll
        for (int q = 0; q < 4; ++q) pre[q] = *(const u32x4*)(kbase + (size_t)(q + 2 < lastst ? q + 2 : lastst) * 4096 + tid * 8);
        __syncthreads();
        bf16x8 kf[2][8]; f32x16 ac[2][2];
#pragma unroll
        for (int j = 0; j < 8; ++j) kf[0][j] = *(const LAS bf16x8*)(lds + rb0 + (j >> 2) * 32 * KPITCH + (j & 3) * 32);
#pragma unroll
        for (int r = 0; r < 16; ++r) { ac[1][0][r] = 0.f; ac[1][1][r] = 0.f; }
#define IDX_RED(P, r) do { s0.x += wv[2 * (r)] * __builtin_amdgcn_fmed3f(P[0][2 * (r)], 0.f, 3.0e38f); s1.x += wv[2 * (r)] * __builtin_amdgcn_fmed3f(P[1][2 * (r)], 0.f, 3.0e38f); \
                           s0.y += wv[2 * (r) + 1] * __builtin_amdgcn_fmed3f(P[0][2 * (r) + 1], 0.f, 3.0e38f); s1.y += wv[2 * (r) + 1] * __builtin_amdgcn_fmed3f(P[1][2 * (r) + 1], 0.f, 3.0e38f); } while (0)
#define IDX_FIN(slot) do { const float p0 = s0.x + s0.y, p1 = s1.x + s1.y; \
            const auto e0_ = __builtin_amdgcn_permlane32_swap(__float_as_uint(p0), __float_as_uint(p0), false, false);     \
            const auto e1_ = __builtin_amdgcn_permlane32_swap(__float_as_uint(p1), __float_as_uint(p1), false, false); \
            const float tot_ = (lane < 32) ? p0 + __uint_as_float(e0_[1]) : p1 + __uint_as_float(e1_[0]);                 \
            sc[(slot) * 64 + lane] = sortable_key(tot_); } while (0)
        for (int s4 = 0; s4 < nst4; s4 += 4) {
#pragma unroll
          for (int q = 0; q < 4; ++q) {
            const int s = s4 + q;
            const int e = q & 1;
            *(LAS u32x4*)(lds + wb0) = pre[q];
            { const int sn = s + 6 < lastst ? s + 6 : lastst; pre[q] = *(const u32x4*)(kbase + (size_t)sn * 4096 + tid * 8); }
            asm volatile("" ::: "memory");
            {
                struct { float x, y; } s0 = {0.f, 0.f}, s1 = {0.f, 0.f};
#pragma unroll
                for (int r = 0; r < 16; ++r) { ac[e][0][r] = 0.f; ac[e][1][r] = 0.f; }
                ac[e][0] = __builtin_amdgcn_mfma_f32_32x32x16_bf16(qa[0], kf[e][0], ac[e][0], 0, 0, 0); IDX_RED(ac[e ^ 1], 0);
                ac[e][1] = __builtin_amdgcn_mfma_f32_32x32x16_bf16(qa[0], kf[e][4], ac[e][1], 0, 0, 0); IDX_RED(ac[e ^ 1], 1);
                ac[e][0] = __builtin_amdgcn_mfma_f32_32x32x16_bf16(qa[1], kf[e][1], ac[e][0], 0, 0, 0); IDX_RED(ac[e ^ 1], 2);
                ac[e][1] = __builtin_amdgcn_mfma_f32_32x32x16_bf16(qa[1], kf[e][5], ac[e][1], 0, 0, 0); IDX_RED(ac[e ^ 1], 3);
                ac[e][0] = __builtin_amdgcn_mfma_f32_32x32x16_bf16(qa[2], kf[e][2], ac[e][0], 0, 0, 0); IDX_RED(ac[e ^ 1], 4);
                ac[e][1] = __builtin_amdgcn_mfma_f32_32x32x16_bf16(qa[2], kf[e][6], ac[e][1], 0, 0, 0); IDX_RED(ac[e ^ 1], 5);
                ac[e][0] = __builtin_amdgcn_mfma_f32_32x32x16_bf16(qa[3], kf[e][3], ac[e][0], 0, 0, 0); IDX_RED(ac[e ^ 1], 6);
                ac[e][1] = __builtin_amdgcn_mfma_f32_32x32x16_bf16(qa[3], kf[e][7], ac[e][1], 0, 0, 0); IDX_RED(ac[e ^ 1], 7);
                IDX_FIN(s > 0 ? s - 1 : 0);
            }
            asm volatile("" ::: "memory");
            __builtin_amdgcn_sched_barrier(0);
#pragma unroll
            for (int j = 0; j < 8; ++j) kf[e ^ 1][j] = *(const LAS bf16x8*)(lds + rb1 + (j >> 2) * 32 * KPITCH + (j & 3) * 32);
            asm volatile("s_waitcnt lgkmcnt(8)" ::: "memory");
            __builtin_amdgcn_s_barrier();
            asm volatile("" ::: "memory");
            __builtin_amdgcn_sched_barrier(0);
            { const unsigned t = rb0; rb0 = rb1; rb1 = rb2; rb2 = t; const unsigned u = wb0; wb0 = wb1; wb1 = wb2; wb2 = u; }
          }
        }
        { struct { float x, y; } s0 = {0.f, 0.f}, s1 = {0.f, 0.f};
#pragma unroll
          for (int r = 0; r < 8; ++r) IDX_RED(ac[1], r);
          IDX_FIN(nst4 - 1); }
        asm volatile("s_waitcnt lgkmcnt(0)" ::: "memory");
        __syncthreads();
#undef IDX_RED
#undef IDX_FIN
        const int n64 = kend >> 6; unsigned prefix = 0u; int need = 256;
        LAS unsigned* hist = (LAS unsigned*)(lds + LDS_KST) + wave * 512;
        LAS unsigned* myh = hist + (lane >> 5) * 256;
        unsigned kr[64];
#pragma unroll
        for (int i = 0; i < 64; ++i) kr[i] = (i < n64) ? sc[64 * i + lane] : 0u;
        int sfin = 0, ncand = 0; bool done = false, fast = false;
#pragma unroll
        for (int pass = 0; pass < 4; ++pass) {
          if (!done) {
            const int shift = 24 - 8 * pass;
            *(LAS u32x4*)(hist + 4 * lane) = (u32x4){0u, 0u, 0u, 0u}; *(LAS u32x4*)(hist + 256 + 4 * lane) = (u32x4){0u, 0u, 0u, 0u};
            asm volatile("s_waitcnt lgkmcnt(0)" ::: "memory");
#pragma unroll
            for (int i = 0; i < 64; ++i) {
                if (i < n64) { const bool m = (pass == 0) || ((kr[i] >> ((shift + 8) & 31)) == prefix);
                    if (m) (void)__hip_atomic_fetch_add(myh + ((kr[i] >> shift) & 255u), 1u, __ATOMIC_RELAXED, __HIP_MEMORY_SCOPE_WORKGROUP); }
            }
            asm volatile("s_waitcnt lgkmcnt(0)" ::: "memory");
            const u32x4 ha = *(LAS u32x4*)(hist + 4 * lane), hc = *(LAS u32x4*)(hist + 256 + 4 * lane);
            const unsigned hb[4] = {ha.x + hc.x, ha.y + hc.y, ha.z + hc.z, ha.w + hc.w};
            const unsigned s = (hb[0] + hb[1]) + (hb[2] + hb[3]); unsigned S = s;
#pragma unroll
            for (int o = 1; o < 64; o <<= 1) { const unsigned t = __shfl_down(S, o); if (lane + o < 64) S += t; }
            const unsigned long long mk = __ballot((int)S >= need);
            const int L = 63 - __builtin_clzll(mk);
            unsigned cum = S - s; int d = 0, nd = need, cbv = 0; bool found = false;
#pragma unroll
            for (int b = 3; b >= 0; --b) { if (!found) { if ((int)(cum + hb[b]) >= need) { d = 4 * lane + b; nd = need - (int)cum; cbv = (int)hb[b]; found = true; } else cum += hb[b]; } }
            d = __builtin_amdgcn_readlane(d, L); need = __builtin_amdgcn_readlane(nd, L); const int cb = __builtin_amdgcn_readlane(cbv, L);
            prefix = (prefix << 8) | (unsigned)d;
            sfin = shift;
            done = (cb == need);
            if (!done && cb <= 64) { done = true; fast = true; ncand = cb; }
          }
        }
        LAS unsigned short* clist = (LAS unsigned short*)hist;
        const unsigned T = prefix; const int G0 = 256 - need;
        int baseG = 0, baseE = 0;
#pragma unroll
        for (int i = 0; i < 64; ++i) { if (i < n64) { const unsigned u = kr[i] >> sfin; const bool gt = u > T, eq = (u == T);
            const unsigned long long mg = __ballot(gt), me = __ballot(eq);
            const int pg = baseG + (int)__builtin_amdgcn_mbcnt_hi((unsigned)(mg >> 32), __builtin_amdgcn_mbcnt_lo((unsigned)mg, 0u));
            if (gt) sel[pg] = (unsigned short)(64 * i + lane);
            baseG += __popcll(mg);
            if (me != 0ull) {
                const int pe = baseE + (int)__builtin_amdgcn_mbcnt_hi((unsigned)(me >> 32), __builtin_amdgcn_mbcnt_lo((unsigned)me, 0u));
                if (fast) { if (eq) clist[pe] = (unsigned short)(64 * i + lane); }
                else if (eq && pe < need) sel[G0 + pe] = (unsigned short)(64 * i + lane);
                baseE += __popcll(me); } } }
        if (fast) {
            asm volatile("s_waitcnt lgkmcnt(0)" ::: "memory");
            const int ci = lane < ncand ? (int)clist[lane] : 0; const unsigned ck = lane < ncand ? sc[ci] : 0u;
            int rk = 0;
            for (int j = 0; j < ncand; ++j) { const unsigned kj = (unsigned)__builtin_amdgcn_readlane((int)ck, j); rk += (kj > ck || (kj == ck && j < lane)) ? 1 : 0; }
            if (lane < ncand && rk < need) sel[G0 + rk] = (unsigned short)ci;
        }
    }
    __syncthreads();
    const int n16 = lane & 15, g4 = lane >> 4;
    bf16x8 qb[4];
    { const bf16_t* qp = (const bf16_t*)(ws + WS_QR) + row * 2048 + n16 * 128 + 8 * g4;
      float x[4][8]; float ssq = 0.f;
#pragma unroll
      for (int ks = 0; ks < 4; ++ks) { const u32x4 raw = *(const u32x4*)(qp + 32 * ks); const unsigned w[4] = {raw.x, raw.y, raw.z, raw.w};
#pragma unroll
          for (int e = 0; e < 4; ++e) { x[ks][2 * e] = bf_lo(w[e]); x[ks][2 * e + 1] = bf_hi(w[e]); ssq += x[ks][2 * e] * x[ks][2 * e] + x[ks][2 * e + 1] * x[ks][2 * e + 1]; } }
      ssq += __shfl_xor(ssq, 16); ssq += __shfl_xor(ssq, 32);
      const float rs = 1.0f / sqrtf(ssq * (1.0f / 128.0f) + EPS);
      const float* qn = p.in[I_QN] + 8 * g4;
#pragma unroll
      for (int ks = 0; ks < 4; ++ks) { const f32x4 ga = *(const f32x4*)(qn + 32 * ks), gb = *(const f32x4*)(qn + 32 * ks + 4);
#pragma unroll
          for (int j = 0; j < 4; ++j) { x[ks][j] *= rs * ga[j]; x[ks][4 + j] *= rs * gb[j]; } }
      const float* cp = (const float*)(ws + WS_COSA) + tok * 64 + 8 * g4; const float* sp = (const float*)(ws + WS_SINA) + tok * 64 + 8 * g4;
#pragma unroll
      for (int ks = 0; ks < 2; ++ks) {
          const f32x4 c0 = *(const f32x4*)(cp + 32 * ks), c1 = *(const f32x4*)(cp + 32 * ks + 4), s0 = *(const f32x4*)(sp + 32 * ks), s1 = *(const f32x4*)(sp + 32 * ks + 4);
          const float cc[8] = {c0[0], c0[1], c0[2], c0[3], c1[0], c1[1], c1[2], c1[3]}, ss[8] = {s0[0], s0[1], s0[2], s0[3], s1[0], s1[1], s1[2], s1[3]};
          unsigned o1[4], o2[4];
#pragma unroll
          for (int e = 0; e < 4; ++e) {
              const float a0 = x[ks][2 * e], a1 = x[ks][2 * e + 1], b0 = x[ks + 2][2 * e], b1 = x[ks + 2][2 * e + 1];
              o1[e] = cvt_pk_bf16(a0 * cc[2 * e] - b0 * ss[2 * e], a1 * cc[2 * e + 1] - b1 * ss[2 * e + 1]);
              o2[e] = cvt_pk_bf16(a0 * ss[2 * e] + b0 * cc[2 * e], a1 * ss[2 * e + 1] + b1 * cc[2 * e + 1]);
          }
          const u32x4 p1 = (u32x4){o1[0], o1[1], o1[2], o1[3]}, p2 = (u32x4){o2[0], o2[1], o2[2], o2[3]};
          qb[ks] = __builtin_bit_cast(bf16x8, p1); qb[ks + 2] = __builtin_bit_cast(bf16x8, p2);
      } }
    const int nck = nsel >> 5;
    f32x4 lg[16];
    {
        LAS unsigned char* vb0 = lds + wave * (2 * VCH);
        const bf16_t* kbase = (const bf16_t*)(ws + WS_KN) + (size_t)b * SEQ * 128 + 8 * n16;
        LAS unsigned char* kput = vb0 + g4 * VROW + n16 * 16;
        const LAS unsigned char* kget = vb0 + n16 * VROW + g4 * 16;
        u32x4 kg[8];
#pragma unroll
        for (int i = 0; i < 8; ++i) kg[i] = *(const u32x4*)(kbase + (size_t)sel[g4 + 4 * i] * 128);
#pragma unroll
        for (int i = 0; i < 8; ++i) *(LAS u32x4*)(kput + 4 * i * VROW) = kg[i];
#pragma unroll
        for (int ck = 0; ck < 8; ++ck) {
            if (ck < nck) {
                const int buf = ck & 1;
                if (ck + 1 < nck) {
#pragma unroll
                    for (int i = 0; i < 8; ++i) kg[i] = *(const u32x4*)(kbase + (size_t)sel[32 * (ck + 1) + g4 + 4 * i] * 128);
                }
#pragma unroll
                for (int t = 0; t < 2; ++t) { f32x4 a = (f32x4){0.f, 0.f, 0.f, 0.f};
#pragma unroll
                    for (int ks = 0; ks < 4; ++ks) { const bf16x8 kf = *(const LAS bf16x8*)(kget + buf * VCH + t * 16 * VROW + ks * 64);
                        a = __builtin_amdgcn_mfma_f32_16x16x32_bf16(kf, qb[ks], a, 0, 0, 0); }
                    lg[2 * ck + t] = a; }
                if (ck + 1 < nck) {
#pragma unroll
                    for (int i = 0; i < 8; ++i) *(LAS u32x4*)(kput + (buf ^ 1) * VCH + 4 * i * VROW) = kg[i];
                }
            } else {
                lg[2 * ck] = (f32x4){-INFINITY, -INFINITY, -INFINITY, -INFINITY}; lg[2 * ck + 1] = (f32x4){-INFINITY, -INFINITY, -INFINITY, -INFINITY};
            }
        }
    }
    float mx = -INFINITY;
#pragma unroll
    for (int kt = 0; kt < 16; ++kt) mx = fmaxf(mx, fmaxf(fmaxf(lg[kt][0], lg[kt][1]), fmaxf(lg[kt][2], lg[kt][3])));
    mx = fmaxf(mx, __shfl_xor(mx, 16)); mx = fmaxf(mx, __shfl_xor(mx, 32));
    const float cexp = 0.08838834764831845f * LOG2E;
    float sum = 0.f;
    bf16x8 pf[8];
#pragma unroll
    for (int ck = 0; ck < 8; ++ck) {
        float pv[8];
#pragma unroll
        for (int r = 0; r < 4; ++r) { pv[r] = __builtin_amdgcn_exp2f((lg[2 * ck][r] - mx) * cexp); pv[4 + r] = __builtin_amdgcn_exp2f((lg[2 * ck + 1][r] - mx) * cexp); }
#pragma unroll
        for (int r = 0; r < 8; ++r) sum += pv[r];
        const u32x4 pw = (u32x4){cvt_pk_bf16(pv[0], pv[1]), cvt_pk_bf16(pv[2], pv[3]), cvt_pk_bf16(pv[4], pv[5]), cvt_pk_bf16(pv[6], pv[7])};
        pf[ck] = __builtin_bit_cast(bf16x8, pw);
    }
    sum += __shfl_xor(sum, 16); sum += __shfl_xor(sum, 32);
    const float inv = 1.0f / sum;
    f32x4 oacc[8];
#pragma unroll
    for (int c = 0; c < 8; ++c) oacc[c] = (f32x4){0.f, 0.f, 0.f, 0.f};
    {
        LAS unsigned char* vb0 = lds + wave * (2 * VCH);
        const bf16_t* vbase = (const bf16_t*)(ws + WS_VB) + (size_t)b * SEQ * 128 + 8 * n16;
        LAS unsigned char* vput = vb0 + g4 * VROW + n16 * 16;
        const LAS s16x4* tb = (const LAS s16x4*)(vb0 + (4 * g4 + (n16 >> 2)) * VROW + 8 * (n16 & 3));
        u32x4 vr[8];
#pragma unroll
        for (int i = 0; i < 8; ++i) vr[i] = *(const u32x4*)(vbase + (size_t)sel[g4 + 4 * i] * 128);
#pragma unroll
        for (int i = 0; i < 8; ++i) *(LAS u32x4*)(vput + 4 * i * VROW) = vr[i];
#pragma unroll
        for (int ck = 0; ck < 8; ++ck) {
            if (ck < nck) {
                const int buf = ck & 1;
                if (ck + 1 < nck) {
#pragma unroll
                    for (int i = 0; i < 8; ++i) vr[i] = *(const u32x4*)(vbase + (size_t)sel[32 * (ck + 1) + g4 + 4 * i] * 128);
                }
#pragma unroll
                for (int c = 0; c < 8; ++c) {
                    const s16x4 r0 = __builtin_amdgcn_ds_read_tr16_b64_v4i16((LAS s16x4*)(tb + (buf * VCH + c * 32) / 8));
                    const s16x4 r1 = __builtin_amdgcn_ds_read_tr16_b64_v4i16((LAS s16x4*)(tb + (buf * VCH + 16 * VROW + c * 32) / 8));
                    const bf16x8 av = (bf16x8){r0[0], r0[1], r0[2], r0[3], r1[0], r1[1], r1[2], r1[3]};
                    oacc[c] = __builtin_amdgcn_mfma_f32_16x16x32_bf16(av, pf[ck], oacc[c], 0, 0, 0);
                }
                if (ck + 1 < nck) {
#pragma unroll
                    for (int i = 0; i < 8; ++i) *(LAS u32x4*)(vput + (buf ^ 1) * VCH + 4 * i * VROW) = vr[i];
                }
            }
        }
    }
    { bf16_t* yb = (bf16_t*)(ws + WS_YB) + row * 2048 + n16 * 128 + 4 * g4;
#pragma unroll
      for (int c = 0; c < 8; ++c) { u32x2 w; w.x = cvt_pk_bf16(oacc[c][0] * inv, oacc[c][1] * inv); w.y = cvt_pk_bf16(oacc[c][2] * inv, oacc[c][3] * inv); *(u32x2*)(yb + 16 * c) = w; } }
    __syncthreads();
}

constexpr int NPHASE = 10;
__global__ void __launch_bounds__(512, 2) mk_fwd(Params p) {
    extern __shared__ __attribute__((aligned(16))) unsigned char lds_raw[];
    LAS unsigned char* lds = (LAS unsigned char*)lds_raw;
    const int tid = threadIdx.x, lane = tid & 63, wave = __builtin_amdgcn_readfirstlane(tid >> 6);
    const int G = (int)gridDim.x;
    unsigned char* ws = p.ws;
    volatile LAS unsigned* MISC = (volatile LAS unsigned*)(lds + MISC_OFF);
    if (tid < 32) MISC[tid] = 0u;
    __syncthreads();
    const XcdBarrier bar = xcd_barrier_post(g_bar, MISC + 8);
    const int lo = p.ph_lo, hi = p.ph_hi;
#define IN(k) (lo <= (k) && (k) < hi)
#define SEAM(k) do { if (IN(k) && IN((k) + 1)) xcd_barrier(bar); } while (0)
    bf16_t* R1 = (bf16_t*)(ws + WS_R1);

    if (IN(0)) { phase_prologue(p, lds, tid, lane, wave); }
    SEAM(0);
    if (IN(0) && IN(1)) {
        if (tid == 0) { bool ok = (G % 8 == 0) && bar.x < 8u;
            for (int j = 0; j < 16; ++j) { const unsigned cj = xb_ld(&g_bar[XB_XCNT(j)]); ok = ok && (cj == (j < 8 ? (unsigned)(G / 8) : 0u)); }
            MISC[11] = ok ? (MISC[10] * 8u + bar.x) : (unsigned)blockIdx.x; }
        __syncthreads();
    } else { if (tid == 0) MISC[11] = (unsigned)blockIdx.x; __syncthreads(); }
    const int cid = (int)MISC[11];
    if (IN(1)) {
        pg8::Gemm g{R1, (const bf16_t*)(ws + WS_W13A), nullptr, nullptr, DM}; pg8::TileOrder<1> S; S.init(MROWS, 2 * DFF, G, cid);
        EpiSwiGLU<USE_FP8_DOWN1 != 0> E{(bf16_t*)(ws + WS_R2), nullptr, 1.0f};
        pg8::gemm_phase(lds, g, S, E);
        {
            constexpr int I_W13 = (DM / 64) * (2 * DFF / 32), I_W2 = (DFF / 64) * (DM / 32);
            const int nwg = (MROWS / 256) * (2 * DFF / 256), rem = nwg % G, c = cid;
            if (rem == 0 || c >= rem) { const int workers = rem == 0 ? G : G - rem, rank = rem == 0 ? c : c - rem;
                conv_items(p, (LAS float*)(lds + wave * 16384), 2 * I_W13 + rank * 8 + wave, workers * 8, 2 * I_W13 + I_W2, 0, 0, lane); }
        }
    }
    SEAM(1);
    if (IN(2)) {
        pg8::Gemm g{(const bf16_t*)(ws + WS_R2), (const bf16_t*)(ws + WS_W2A), nullptr, nullptr, USE_FP8_DOWN1 ? DFF / 2 : DFF}; pg8::TileOrder<1> S; S.init(MROWS, DM, G, cid);
        using EpiH1 = EpiRes<false, false, true, true, true>;
        EpiH1 E{p.in[I_X], nullptr, R1, (float*)(ws + WS_SS2P), ws + WS_H1B8, USE_FP8_DOWN1 ? 0.5f / (G8_SCALE * W8_SCALE) : 0.5f};
        pg8::gemm_phase<EpiH1, pg8::TileOrder<1>, USE_FP8_DOWN1 != 0>(lds, g, S, E);
    }
    SEAM(2);
    if (IN(3)) {
        LAS float* rsl = (LAS float*)(lds + LDS_RS);
        { pg8::TileOrder<1> S0; S0.init(MROWS, NIN_A, G, cid); Unit u0; S0.next(0, u0); panel_rs((const float*)(ws + WS_SS2P), u0.pm, rsl, tid); }
        { pg8::Gemm g{R1, (const bf16_t*)(ws + WS_WIN), nullptr, nullptr, DM}; pg8::TileOrder<1> S; S.init(MROWS, NIN_A, G, cid);
          EpiIn<0> E{rsl, (bf16_t*)(ws + WS_U), (bf16_t*)(ws + WS_V), (bf16_t*)(ws + WS_QR), (bf16_t*)(ws + WS_QIR), (float*)(ws + WS_KVR), ws + WS_R3, p.in[I_GBIAS], (float*)(ws + WS_SSVP)};
          pg8::gemm_phase(lds, g, S, E); }
        { pg8::Gemm g{(const bf16_t*)(ws + WS_H1B8), (const bf16_t*)(ws + WS_WINB8), nullptr, nullptr, DM / 2};
          EpiIn<1> E{rsl, (bf16_t*)(ws + WS_U), (bf16_t*)(ws + WS_V), (bf16_t*)(ws + WS_QR), (bf16_t*)(ws + WS_QIR), (float*)(ws + WS_KVR), ws + WS_R3, p.in[I_GBIAS], (float*)(ws + WS_SSVP)};
          pg8::SplitOrTile<MROWS, NIN_B, 5, 7> S{G, cid};
          pg8::gemm_phase<EpiIn<1>, pg8::SplitOrTile<MROWS, NIN_B, 5, 7>, true>(lds, g, S, E); }
    }
    SEAM(3);
    if (IN(4)) { phase_post(p, lane, wave); }
    SEAM(4);
    if (IN(5)) {
        gmlp_units(p, lds, G, tid, lane, wave);
        for (int pr = (int)blockIdx.x; pr < 1024; pr += G) { const int b = pr >> 8, j = pr & 255; dsa_unit(p, lds, b, j, tid, lane, wave); dsa_unit(p, lds, b, 511 - j, tid, lane, wave); }
    }
    SEAM(5);
    if (IN(6)) {
        pg8::Gemm g{(const bf16_t*)(ws + WS_YA), (const bf16_t*)(ws + WS_WA), (const bf16_t*)(ws + WS_YB), (const bf16_t*)(ws + WS_WB), GW}; pg8::TileOrder<2> S; S.init(MROWS, DM, G, cid);
        EpiMerge E{ws + WS_R3, (bf16_t*)p.out};
        pg8::gemm_phase(lds, g, S, E);
    }
    SEAM(6);
    if (IN(7)) {
        pg8::Gemm g{(const bf16_t*)p.out, (const bf16_t*)(ws + WS_WOUT), nullptr, nullptr, DM}; pg8::TileOrder<1> S; S.init(MROWS, DM, G, cid);
        using EpiH2 = EpiRes<true, false, true, USE_FP8_UP2 != 0, true>;
        EpiH2 E{R1, nullptr, (bf16_t*)(ws + WS_R3), (float*)(ws + WS_SS3P), ws + WS_H2B8, 1.0f};
        pg8::gemm_phase(lds, g, S, E);
    }
    SEAM(7);
    if (IN(8)) {
        pg8::TileOrder<1> S; S.init(MROWS, 2 * DFF, G, cid);
        LAS float* rsl = (LAS float*)(lds + LDS_RS);
        { Unit u0; S.next(0, u0); panel_rs((const float*)(ws + WS_SS3P), u0.pm, rsl, tid); }
        if (USE_FP8_UP2) {
            pg8::Gemm g{(const bf16_t*)(ws + WS_H2B8), (const bf16_t*)(ws + WS_W13B), nullptr, nullptr, DM / 2};
            EpiSwiGLU<USE_FP8_DOWN != 0> E{(bf16_t*)(ws + WS_R2), rsl, 1.0f / (H8_SCALE * WIN8_SCALE)};
            pg8::gemm_phase<EpiSwiGLU<USE_FP8_DOWN != 0>, pg8::TileOrder<1>, USE_FP8_UP2 != 0>(lds, g, S, E);
        } else {
            pg8::Gemm g{(const bf16_t*)(ws + WS_R3), (const bf16_t*)(ws + WS_W13B), nullptr, nullptr, DM};
            EpiSwiGLU<USE_FP8_DOWN != 0> E{(bf16_t*)(ws + WS_R2), rsl, 1.0f};
            pg8::gemm_phase(lds, g, S, E);
        }
        {
            constexpr int I_W13 = (DM / 64) * (2 * DFF / 32), I_W2 = (DFF / 64) * (DM / 32);
            const int nwg = (MROWS / 256) * (2 * DFF / 256), rem = nwg % G, c = cid;
            if (rem == 0 || c >= rem) { const int workers = rem == 0 ? G : G - rem, rank = rem == 0 ? c : c - rem;
                conv_items(p, (LAS float*)(lds + wave * 16384), 2 * I_W13 + I_W2 + I_W2 / 2 + rank * 8 + wave, workers * 8, 2 * I_W13 + 2 * I_W2, 0, 0, lane); }
        }
    }
    SEAM(8);
    if (IN(9)) {
        pg8::Gemm g{(const bf16_t*)(ws + WS_R2), (const bf16_t*)(ws + WS_W2B), nullptr, nullptr, USE_FP8_DOWN ? DFF / 2 : DFF}; pg8::TileOrder<1> S; S.init(MROWS, DM, G, cid);
        using EpiOut = EpiRes<true, true, false, false, false>;
        EpiOut E{(const bf16_t*)(ws + WS_R3), p.out, nullptr, nullptr, nullptr, USE_FP8_DOWN ? 0.5f / (G8_SCALE * W8_SCALE) : 0.5f};
        pg8::gemm_phase<EpiOut, pg8::TileOrder<1>, USE_FP8_DOWN != 0>(lds, g, S, E);
    }
    {
        if (xb_ld(&g_bar[XB_TMO]) != 0u) { const float q = __builtin_nanf(""); asm volatile("s_waitcnt vmcnt(0)" ::: "memory"); __syncthreads();
            for (size_t i = (size_t)blockIdx.x * 512 + tid; i < (size_t)MROWS * DM / 4; i += (size_t)G * 512) ((f32x4*)p.out)[i] = (f32x4){q, q, q, q}; }
        xcd_barrier_retire(g_bar);
    }
#undef IN
#undef SEAM
}

extern "C" void kernel_launch(void* const* d_in, const int* in_sizes, int n_in, void* d_out, int out_size, void* d_ws, size_t ws_size, hipStream_t stream) {
    static int grid = 0;
    if (grid == 0) {
        if (n_in != 21 || out_size != MROWS * DM || ws_size < WS_END) { fprintf(stderr, "kernel_launch: unexpected shapes (n_in %d, out %d, ws %zu); nothing launched\n", n_in, out_size, ws_size); grid = -1; return; }
        int dev = 0, cus = 0, per_cu = 0;
        if (hipGetDevice(&dev) != hipSuccess || hipDeviceGetAttribute(&cus, hipDeviceAttributeMultiprocessorCount, dev) != hipSuccess) { grid = -1; return; }
        if (hipFuncSetAttribute((const void*)mk_fwd, hipFuncAttributeMaxDynamicSharedMemorySize, LDS_BYTES) != hipSuccess) { fprintf(stderr, "kernel_launch: hipFuncSetAttribute failed\n"); grid = -1; return; }
        if (hipOccupancyMaxActiveBlocksPerMultiprocessor(&per_cu, (const void*)mk_fwd, 512, LDS_BYTES) != hipSuccess || per_cu < 1)
            fprintf(stderr, "kernel_launch: occupancy query reports %d workgroups per CU\n", per_cu);
        (void)hipGetLastError();
        grid = cus;
    }
    if (grid < 0) return;
    Params a{};
    for (int i = 0; i < 21; ++i) a.in[i] = (const float*)d_in[i];
    a.out = (float*)d_out; a.ws = (unsigned char*)d_ws;
    a.ph_lo = 0; a.ph_hi = NPHASE;
    hipLaunchKernelGGL(mk_fwd, dim3(grid), dim3(512), LDS_BYTES, stream, a);
}
```

```cpp
#include <hip/hip_runtime.h>
#include <cstdio>
#include <cstdint>


#define LAS __attribute__((address_space(3)))
typedef unsigned short bf16_t;
typedef short bf16x8 __attribute__((ext_vector_type(8)));
typedef float f32x4 __attribute__((ext_vector_type(4)));
typedef float f32x16 __attribute__((ext_vector_type(16)));
typedef unsigned u32x4 __attribute__((ext_vector_type(4)));
typedef unsigned u32x2 __attribute__((ext_vector_type(2)));

constexpr int DM = 4096, NBATCH = 4, SEQ = 4096, MROWS = NBATCH * SEQ;
constexpr int DFF = 11008, GW = 2048, AW = 2048, HD = 128, NH = 16, IH = 32, IDM = 64;
constexpr int NIN = 16896;
constexpr int NGATE = 8192;
constexpr int KVW = 352;
constexpr float EPS = 1e-6f;
constexpr float IDX_SCALE = 0.02209708691207961f;
constexpr float LOG2E = 1.4426950408889634f;
#ifndef USE_FP8_UP2
#define USE_FP8_UP2 1
#endif
#ifndef USE_FP8_DOWN1
#define USE_FP8_DOWN1 0
#endif
#ifndef USE_FP8_DOWN
#define USE_FP8_DOWN 1
#endif
constexpr float H8_SCALE = 8.0f, WIN8_SCALE = 64.0f;
constexpr int NIN_A = 42 * 256, NIN_B = 24 * 256;
constexpr float G8_SCALE = 4.0f, W8_SCALE = 128.0f;

constexpr size_t MiB = 1u << 20;
constexpr size_t WS_CTL = 0, CTL_ZERO_BYTES = 256 * 1024;
constexpr size_t CTL_BAR_BYTE = 16384;
constexpr size_t CTL_SS2 = 64 * 1024, CTL_SS3 = 128 * 1024, CTL_SSV = 192 * 1024;
constexpr size_t WS_W13A = 1 * MiB;
constexpr size_t WS_W2A = WS_W13A + 172 * MiB;
constexpr size_t WS_WIN = WS_W2A + 86 * MiB;
constexpr size_t WS_WA = WS_WIN + 132 * MiB;
constexpr size_t WS_WB = WS_WA + 16 * MiB;
constexpr size_t WS_WOUT = WS_WB + 16 * MiB;
constexpr size_t WS_W13B = WS_WOUT + 32 * MiB;
constexpr size_t WS_W2B = WS_W13B + 172 * MiB;
constexpr size_t WS_R1 = WS_W2B + 86 * MiB;
constexpr size_t WS_R2 = WS_R1 + 128 * MiB;
constexpr size_t WS_R3 = WS_R2 + 344 * MiB;
constexpr size_t WS_R4 = WS_R3 + 256 * MiB;
constexpr size_t WS_U = WS_R2, WS_V = WS_R2 + 64 * MiB, WS_QR = WS_R2 + 128 * MiB, WS_QIR = WS_R2 + 192 * MiB, WS_KVR = WS_R2 + 256 * MiB, WS_YA = WS_R2 + 279 * MiB;
static_assert((size_t)MROWS * KVW * 4 <= 23 * MiB && WS_YA + 64 * MiB <= WS_R3, "R2 overlay");
constexpr size_t WS_YB = WS_R4, WS_KN = WS_R4 + 64 * MiB, WS_VB = WS_KN + 4 * MiB, WS_KIN = WS_VB + 4 * MiB, WS_WI = WS_KIN + 2 * MiB;
constexpr size_t WS_COSA = WS_WI + 2 * MiB, WS_SINA = WS_COSA + 1 * MiB, WS_COSI = WS_SINA + 1 * MiB, WS_SINI = WS_COSI + 512 * 1024, WS_WS16 = WS_SINI + 512 * 1024;
constexpr size_t WS_WINB8 = WS_WIN + 84 * MiB;
constexpr size_t WS_H2B8 = WS_R3 + 128 * MiB;
constexpr size_t WS_H1B8 = WS_YB;
constexpr size_t WS_SS2P = WS_WS16 + 1 * MiB, WS_SS3P = WS_SS2P + 4 * MiB, WS_SSVP = WS_SS3P + 4 * MiB;
constexpr size_t WS_END = WS_SSVP + 2 * MiB;
static_assert(WS_END <= (size_t)1600 * MiB, "workspace budget");

constexpr int LDS_SC = 0;
constexpr int LDS_KST = 131072;
constexpr int KPITCH = 144, KSTG = 64 * KPITCH;
constexpr int LDS_SEL = LDS_KST + 3 * KSTG;
constexpr int LDS_RS = 131072;
constexpr int MISC_OFF = LDS_SEL + 4096;
constexpr int LDS_BYTES = MISC_OFF + 128;
static_assert(LDS_BYTES <= 160 * 1024 && 3 * KSTG >= 16384, "LDS map");

__device__ __forceinline__ unsigned cvt_pk_bf16(float lo, float hi) { unsigned r; asm volatile("s_nop 0\n\tv_cvt_pk_bf16_f32 %0, %1, %2" : "=v"(r) : "v"(lo), "v"(hi)); return r; }
__device__ __forceinline__ float bf_lo(unsigned w) { return __uint_as_float(w << 16); }
__device__ __forceinline__ float bf_hi(unsigned w) { return __uint_as_float(w & 0xffff0000u); }
__device__ __forceinline__ float wave_sum(float v) {
#pragma unroll
    for (int o = 1; o < 64; o <<= 1) v += __shfl_xor(v, o);
    return v;
}
__device__ __forceinline__ float sigmoid_f(float z) { return __builtin_amdgcn_rcpf(1.0f + __builtin_amdgcn_exp2f(-z * LOG2E)); }
typedef float f32x2 __attribute__((ext_vector_type(2)));
__device__ __forceinline__ f32x2 gelu_pk(f32x2 v) {
    const f32x2 av = __builtin_elementwise_abs(v), d = av * 0.2316418882f + 1.0f;
    f32x2 t; t.x = __builtin_amdgcn_rcpf(d.x); t.y = __builtin_amdgcn_rcpf(d.y);
    f32x2 q = t * 0.5307027145f + (-0.7265760135f); q = q * t + 0.7107068705f; q = q * t + (-0.142248368f); q = q * t + 0.127414796f; q = q * t;
    const f32x2 s = (v * v) * (-0.72134752044f);
    f32x2 e; e.x = __builtin_amdgcn_exp2f(s.x); e.y = __builtin_amdgcn_exp2f(s.y);
    const f32x2 m = v * (q * e), r = v - m;
    f32x2 o; o.x = v.x < 0.f ? m.x : r.x; o.y = v.y < 0.f ? m.y : r.y; return o;
}
__device__ __forceinline__ f32x4 gelu4(f32x4 v) { const f32x2 a = gelu_pk((f32x2){v[0], v[1]}), b = gelu_pk((f32x2){v[2], v[3]}); return (f32x4){a.x, a.y, b.x, b.y}; }

#define XB_TMO      128
#define XB_XCNT(j)  (256  + 64 * (j))
#define XB_XSUB(j)  (1280 + 64 * (j))
#define XB_XGEN(j)  (2304 + 64 * (j))
#define XB_TOP      3328
#define XB_TOPGEN   3392
#define XCD_BAR_WORDS 3456
#define XB_SPIN_CAP (1u << 18)
__device__ __forceinline__ unsigned xb_ld(unsigned* p)              { return __hip_atomic_load(p, __ATOMIC_RELAXED, __HIP_MEMORY_SCOPE_AGENT); }
__device__ __forceinline__ unsigned xb_add(unsigned* p, unsigned v) { return __hip_atomic_fetch_add(p, v, __ATOMIC_RELAXED, __HIP_MEMORY_SCOPE_AGENT); }
__device__ __forceinline__ unsigned xb_xcc_id() { return (unsigned)__builtin_amdgcn_s_getreg((3 << 11) | 20) & 0xFu; }
#define XB_SPIN(cond, bar) do { unsigned _sp = 0; while (cond) { __builtin_amdgcn_s_sleep(1); \
    if ((++_sp & 255u) == 0u) { if (xb_ld(&(bar)[XB_TMO])) break; if (_sp > XB_SPIN_CAP) { atomicAdd(&(bar)[XB_TMO], 1u); break; } } } } while (0)
#define XB_DONE XCD_BAR_WORDS
__device__ unsigned g_bar[XCD_BAR_WORDS + 64];
struct XcdBarrier { unsigned* bar; unsigned x; volatile LAS unsigned* st; };
__device__ __forceinline__ void xb_st0(unsigned* p) { __hip_atomic_store(p, 0u, __ATOMIC_RELAXED, __HIP_MEMORY_SCOPE_AGENT); }
__device__ __forceinline__ void xcd_barrier_retire(unsigned* bar) {
    __syncthreads();
    if (threadIdx.x == 0) {
        const unsigned G = gridDim.x * gridDim.y * gridDim.z;
        if (xb_add(&bar[XB_DONE], 1u) == G - 1u) {
#pragma unroll
            for (int j = 0; j < 16; ++j) { xb_st0(&bar[XB_XCNT(j)]); xb_st0(&bar[XB_XSUB(j)]); xb_st0(&bar[XB_XGEN(j)]); }
            xb_st0(&bar[XB_TOP]); xb_st0(&bar[XB_TOPGEN]); xb_st0(&bar[XB_TMO]); xb_st0(&bar[XB_DONE]);
        }
    }
}
__device__ __forceinline__ XcdBarrier xcd_barrier_post(unsigned* bar, volatile LAS unsigned* st) {
    XcdBarrier b; b.bar = bar; b.x = xb_xcc_id(); b.st = st;
    if (threadIdx.x == 0) st[2] = xb_add(&bar[XB_XCNT(b.x)], 1u);
    return b;
}
__device__ __forceinline__ void xcd_barrier_complete(unsigned* bar, unsigned x, unsigned& nloc, unsigned& nx) {
    const unsigned G = gridDim.x * gridDim.y * gridDim.z;
    unsigned sum, cnt, mine, sp = 0u;
    for (;;) {
        sum = 0u; cnt = 0u; mine = 0u;
#pragma unroll
        for (unsigned j = 0; j < 16; ++j) { const unsigned c = xb_ld(&bar[XB_XCNT(j)]); sum += c; cnt += (c > 0u) ? 1u : 0u; mine = (j == x) ? c : mine; }
        if (sum == G) break;
        __builtin_amdgcn_s_sleep(1);
        if ((++sp & 255u) == 0u) { if (xb_ld(&bar[XB_TMO])) break; if (sp > XB_SPIN_CAP) { atomicAdd(&bar[XB_TMO], 1u); break; } }
    }
    nloc = mine > 0u ? mine : 1u; nx = cnt > 0u ? cnt : 1u;
}
__device__ __forceinline__ void xcd_barrier(const XcdBarrier& b) {
    asm volatile("s_waitcnt vmcnt(0)" ::: "memory");
    __syncthreads();
    if (threadIdx.x == 0) {
        unsigned* bar = b.bar;
        __builtin_amdgcn_s_waitcnt(0);
        unsigned nloc = b.st[0], nx = b.st[1];
        if (nloc == 0u) { xcd_barrier_complete(bar, b.x, nloc, nx); b.st[0] = nloc; b.st[1] = nx; }
        const unsigned old = xb_add(&bar[XB_XSUB(b.x)], 1u);
        const unsigned gen = old / nloc;
        if (old + 1u == (gen + 1u) * nloc) {
            __builtin_amdgcn_fence(__ATOMIC_RELEASE, "agent");
            asm volatile("s_waitcnt vmcnt(0)" ::: "memory");
            const unsigned og = xb_add(&bar[XB_TOP], 1u);
            const unsigned tg = og / nx;
            if (og + 1u == (tg + 1u) * nx) xb_add(&bar[XB_TOPGEN], 1u);
            else XB_SPIN(xb_ld(&bar[XB_TOPGEN]) == tg, bar);
            __builtin_amdgcn_fence(__ATOMIC_ACQUIRE, "agent");
            xb_add(&bar[XB_XGEN(b.x)], 1u);
            asm volatile("s_waitcnt vmcnt(0)" ::: "memory");
        } else {
            XB_SPIN(xb_ld(&bar[XB_XGEN(b.x)]) == gen, bar);
            __builtin_amdgcn_fence(__ATOMIC_ACQUIRE, "agent");
            asm volatile("s_waitcnt vmcnt(0)" ::: "memory");
        }
    }
    __syncthreads();
}

namespace pg8 {
constexpr int BM = 256, BK = 64, HALF = 128, HTB = HALF * BK * 2, STAGE_BYTES = 8 * HTB, NXCD = 8, WGM = 8;
__device__ __forceinline__ int lds_byte(int r, int c) { const int st = (r >> 4) * 2 + (c >> 5), rr = r & 15, cc = c & 31, ob = rr * 64 + cc * 2; return st * 1024 + (ob ^ (((ob >> 9) & 1) << 5)); }
__device__ __forceinline__ void stage_rc(int b, int& R, int& C) { const int st = b / 1024, sb = b % 1024, swz = sb ^ (((sb >> 9) & 1) << 5); R = (st >> 1) * 16 + swz / 64; C = (st & 1) * 32 + (swz % 64) / 2; }
__device__ __forceinline__ int perm32(int rho) { const int n = rho >> 4, i = rho & 15; return 8 * (i >> 2) + 4 * n + (i & 3); }
struct Unit { int pm, pn, seg; };
struct Gemm { const bf16_t* A0; const bf16_t* B0; const bf16_t* A1; const bf16_t* B1; int K; };
template <int NSEG> struct TileOrder {
    int nM, nN, nwg, G, c;
    __device__ __forceinline__ void init(int M, int N, int G_, int c_) { nM = M / BM; nN = N / BM; nwg = nM * nN; G = G_; c = c_; }
    __device__ __forceinline__ bool next(int i, Unit& u) const {
        const int ti = i / NSEG; u.seg = i % NSEG;
        const long L = (long)ti * G + c; if (L >= nwg) return false;
        int wgid = (int)L; { const int q = nwg / NXCD, r = nwg % NXCD, xcd = wgid % NXCD, off = wgid / NXCD; wgid = (xcd < r ? xcd * (q + 1) : r * (q + 1) + (xcd - r) * q) + off; }
        const int nig = WGM * nN, gid = wgid / nig, fm = gid * WGM, gsz = (nM - fm) < WGM ? (nM - fm) : WGM;
        u.pm = fm + ((wgid % nig) % gsz); u.pn = (wgid % nig) / gsz; return true;
    }
};
struct SplitOrder {
    int pm, base, cnt;
    __device__ __forceinline__ void init(int c, int nlo, int nhi) { const int k = c >> 6; pm = 8 * (c & 7) + ((c >> 3) & 7); base = k < 2 ? k * nlo : 2 * nlo + (k - 2) * nhi; cnt = k < 2 ? nlo : nhi; }
    __device__ __forceinline__ bool next(int i, Unit& u) const { if (i >= cnt) return false; u.pm = pm; u.pn = base + i; u.seg = 0; return true; }
};
template <int M, int N, int NLO, int NHI> struct SplitOrTile {
    int G, c;
    __device__ __forceinline__ bool next(int i, Unit& u) const {
        if (G == 256) { SplitOrder s; s.init(c, NLO, NHI); return s.next(i, u); }
        TileOrder<1> t; t.init(M, N, G, c); return t.next(i, u);
    }
};
typedef int v8i_t __attribute__((ext_vector_type(8)));
typedef int v4i_t __attribute__((ext_vector_type(4)));
__device__ __forceinline__ v8i_t cat8(bf16x8 a, bf16x8 b) { const v4i_t x = __builtin_bit_cast(v4i_t, a), y = __builtin_bit_cast(v4i_t, b); return __builtin_shufflevector(x, y, 0, 1, 2, 3, 4, 5, 6, 7); }
template <class Epi, class Sched, bool FP8 = false>
__device__ __forceinline__ void gemm_phase(LAS unsigned char* lds, const Gemm g, const Sched& S, const Epi& E) {
    const int tid = threadIdx.x, wid = __builtin_amdgcn_readfirstlane(tid >> 6), lane = tid & 63, wr = wid >> 2, wc = wid & 3, fr = lane & 15, fq = lane >> 4;
    const int K = g.K, nt = K / BK;
    unsigned voffA[2], voffB[2];
#pragma unroll
    for (int i = 0; i < 2; ++i) { int R, C; stage_rc(tid * 16 + i * 8192, R, C); const int Rb = (R & ~31) + perm32(R & 31);
        voffA[i] = (unsigned)(R * K + C) * 2u; voffB[i] = (unsigned)(Rb * K + C) * 2u; }
    const size_t kstep = (size_t)(BK * 2);
    const size_t hstep = (size_t)HALF * K * 2;
    const size_t tstep = 2 * hstep;
    const unsigned ldsw = (unsigned)wid * 1024u;
    const int aoff = lds_byte(wr * 64 + fr, fq * 8), boff = lds_byte(wc * 32 + fr, fq * 8);
#define PG8_SA(b, h) (((b) * 2 + (h)) * HTB)
#define PG8_SB(b, h) ((4 + (b) * 2 + (h)) * HTB)
#define PG8_STAGE(bufoff, gbase, voff) do { _Pragma("unroll") for (int _i = 0; _i < 2; ++_i) \
        __builtin_amdgcn_global_load_lds((const unsigned*)((const char*)(gbase) + (voff)[_i]), (LAS unsigned*)(lds + (bufoff) + ldsw + _i * 8192), 16, 0, 0); } while (0)
#define PG8_LDA(dst, b, h) do { _Pragma("unroll") for (int m = 0; m < 4; ++m) { const bf16x8 _x0 = *(const LAS bf16x8*)(lds + PG8_SA(b, h) + aoff + m * 2048), _x1 = *(const LAS bf16x8*)(lds + PG8_SA(b, h) + aoff + m * 2048 + 1024); \
        if constexpr (FP8) dst##8[m] = cat8(_x0, _x1); else { dst[m][0] = _x0; dst[m][1] = _x1; } } } while (0)
#define PG8_LDB(dst, b, h) do { _Pragma("unroll") for (int n = 0; n < 2; ++n) { const bf16x8 _x0 = *(const LAS bf16x8*)(lds + PG8_SB(b, h) + boff + n * 2048), _x1 = *(const LAS bf16x8*)(lds + PG8_SB(b, h) + boff + n * 2048 + 1024); \
        if constexpr (FP8) dst##8[n] = cat8(_x0, _x1); else { dst[n][0] = _x0; dst[n][1] = _x1; } } } while (0)
#define PG8_MMA(ai, bj, At, Bt) do { __builtin_amdgcn_s_setprio(1); if constexpr (FP8) { _Pragma("unroll") for (int m = 0; m < 4; ++m) _Pragma("unroll") for (int n = 0; n < 2; ++n) \
        asm volatile("v_mfma_f32_16x16x128_f8f6f4 %0, %1, %2, %0" : "+v"(acc[ai][bj][m][n]) : "v"(Bt##8[n]), "v"(At##8[m])); } \
        else { _Pragma("unroll") for (int m = 0; m < 4; ++m) _Pragma("unroll") for (int n = 0; n < 2; ++n) _Pragma("unroll") for (int k = 0; k < 2; ++k) \
        acc[ai][bj][m][n] = __builtin_amdgcn_mfma_f32_16x16x32_bf16(Bt[n][k], At[m][k], acc[ai][bj][m][n], 0, 0, 0); } __builtin_amdgcn_s_setprio(0); } while (0)
#define PG8_WAIT_V(n) asm volatile("s_waitcnt vmcnt(" #n ")" ::: "memory")
#define PG8_WAIT_L(n) asm volatile("s_waitcnt lgkmcnt(" #n ")" ::: "memory")
#define PG8_BAR __builtin_amdgcn_s_barrier()
#define PG8_SCHED __builtin_amdgcn_sched_barrier(0)
    Unit cur, nxt; int ui = 0;
    if (!S.next(0, cur)) return;
    f32x4 acc[2][2][4][2];
#pragma unroll
    for (int a = 0; a < 2; ++a)
#pragma unroll
        for (int b = 0; b < 2; ++b)
#pragma unroll
            for (int m = 0; m < 4; ++m)
#pragma unroll
                for (int n = 0; n < 2; ++n) acc[a][b][m][n] = (f32x4){0.f, 0.f, 0.f, 0.f};
    bf16x8 At[4][2], B0[2][2], B1[2][2];
    v8i_t At8[4], B08[2], B18[2];
    const char* cA = (const char*)(cur.seg ? g.A1 : g.A0) + (size_t)cur.pm * tstep; const char* cB = (const char*)(cur.seg ? g.B1 : g.B0) + (size_t)cur.pn * tstep;
    PG8_STAGE(PG8_SB(0, 0), cB, voffB); PG8_STAGE(PG8_SB(0, 1), cB + hstep, voffB); PG8_STAGE(PG8_SA(0, 0), cA, voffA); PG8_STAGE(PG8_SA(0, 1), cA + hstep, voffA);
    if (wr == 1) PG8_BAR;
    PG8_WAIT_V(2); PG8_BAR;
    PG8_STAGE(PG8_SB(1, 0), cB + kstep, voffB); PG8_STAGE(PG8_SA(1, 0), cA + kstep, voffA); PG8_STAGE(PG8_SB(1, 1), cB + hstep + kstep, voffB);
    PG8_WAIT_V(6); PG8_BAR;
    for (;;) {
        const bool has_next = S.next(ui + 1, nxt);
        const char* nA = has_next ? (const char*)(nxt.seg ? g.A1 : g.A0) + (size_t)nxt.pm * tstep : cA; const char* nB = has_next ? (const char*)(nxt.seg ? g.B1 : g.B0) + (size_t)nxt.pn * tstep : cB;
        for (int t = 0; t < nt; t += 2) {
            const bool last = (t == nt - 2);
            const char* a1 = cA + (size_t)(t + 1) * kstep;
            const char* a2 = last ? nA : cA + (size_t)(t + 2) * kstep; const char* b2 = last ? nB : cB + (size_t)(t + 2) * kstep;
            const char* a3 = a2 + kstep; const char* b3 = b2 + kstep;
            PG8_LDB(B0, 0, 0); PG8_LDB(B1, 0, 1); PG8_SCHED; PG8_LDA(At, 0, 0); PG8_STAGE(PG8_SA(1, 1), a1 + hstep, voffA);
            PG8_WAIT_V(8); PG8_WAIT_L(0); PG8_BAR; PG8_MMA(0, 0, At, B0); PG8_MMA(0, 1, At, B1); PG8_BAR; PG8_SCHED;
            PG8_LDA(At, 0, 1); PG8_STAGE(PG8_SB(0, 0), b2, voffB); PG8_STAGE(PG8_SB(0, 1), b2 + hstep, voffB); PG8_STAGE(PG8_SA(0, 0), a2, voffA);
            PG8_WAIT_V(8); PG8_WAIT_L(0); PG8_BAR; PG8_MMA(1, 0, At, B0); PG8_MMA(1, 1, At, B1); PG8_BAR; PG8_SCHED;
            PG8_LDB(B0, 1, 0); PG8_LDB(B1, 1, 1); PG8_SCHED; PG8_LDA(At, 1, 0); PG8_STAGE(PG8_SA(0, 1), a2 + hstep, voffA);
            PG8_WAIT_V(8); PG8_WAIT_L(0); PG8_BAR; PG8_MMA(0, 0, At, B0); PG8_MMA(0, 1, At, B1); PG8_BAR; PG8_SCHED;
            PG8_LDA(At, 1, 1); PG8_STAGE(PG8_SB(1, 0), b3, voffB); PG8_STAGE(PG8_SB(1, 1), b3 + hstep, voffB); PG8_STAGE(PG8_SA(1, 0), a3, voffA);
            PG8_WAIT_V(8); PG8_WAIT_L(0); PG8_BAR; PG8_MMA(1, 0, At, B0); PG8_MMA(1, 1, At, B1); PG8_BAR; PG8_SCHED;
        }
        if (wr == 0) PG8_BAR;
        if constexpr (FP8) asm volatile("s_nop 15\n\ts_nop 15\n\ts_nop 15\n\ts_nop 15\n\ts_nop 15\n\ts_nop 15\n\ts_nop 15\n\ts_nop 15" ::: "memory");
        const bool keep = E(acc, cur, wr, wc, fr, fq);
        if (!has_next) break;
        if (!keep) {
#pragma unroll
            for (int a = 0; a < 2; ++a)
#pragma unroll
                for (int b = 0; b < 2; ++b)
#pragma unroll
                    for (int m = 0; m < 4; ++m)
#pragma unroll
                        for (int n = 0; n < 2; ++n) acc[a][b][m][n] = (f32x4){0.f, 0.f, 0.f, 0.f};
        }
        cur = nxt; cA = nA; cB = nB; ++ui;
        if (wr == 1) PG8_BAR;
    }
    PG8_WAIT_V(0);
    PG8_BAR;
#undef PG8_SA
#undef PG8_SB
#undef PG8_STAGE
#undef PG8_LDA
#undef PG8_LDB
#undef PG8_MMA
#undef PG8_WAIT_V
#undef PG8_WAIT_L
#undef PG8_BAR
#undef PG8_SCHED
}
}
using pg8::Unit;

template <bool OUT8> struct EpiSwiGLU {
    bf16_t* G; const LAS float* ss; float pre;
    __device__ __forceinline__ bool operator()(f32x4 (&acc)[2][2][4][2], const Unit& u, int wr, int wc, int fr, int fq) const {
        const int row0 = u.pm * 256 + wr * 64 + fr, col0 = u.pn * 128 + wc * 32 + 8 * fq;
        float rsv[2][4];
#pragma unroll
        for (int ai = 0; ai < 2; ++ai)
#pragma unroll
            for (int m = 0; m < 4; ++m) rsv[ai][m] = ss ? ss[ai * 128 + wr * 64 + m * 16 + fr] : 1.f;
#pragma unroll
        for (int ai = 0; ai < 2; ++ai)
#pragma unroll
            for (int m = 0; m < 4; ++m) {
                const int row = row0 + ai * 128 + m * 16;
                const float rs = pre * rsv[ai][m];
                const float c1 = -LOG2E * rs, ik2 = __builtin_amdgcn_rcpf(OUT8 ? rs * rs * G8_SCALE : rs * rs);
                float o[8];
#pragma unroll
                for (int n = 0; n < 2; ++n)
#pragma unroll
                    for (int j = 0; j < 4; j += 2) {
                        const f32x2 A = (f32x2){acc[ai][0][m][n][j], acc[ai][0][m][n][j + 1]}, B = (f32x2){acc[ai][1][m][n][j], acc[ai][1][m][n][j + 1]};
                        const f32x2 t = A * c1; f32x2 e; e.x = __builtin_amdgcn_exp2f(t.x); e.y = __builtin_amdgcn_exp2f(t.y);
                        const f32x2 d = e * ik2 + ik2; f32x2 r; r.x = __builtin_amdgcn_rcpf(d.x); r.y = __builtin_amdgcn_rcpf(d.y);
                        const f32x2 q = (A * B) * r; o[4 * n + j] = q.x; o[4 * n + j + 1] = q.y; }
                if constexpr (OUT8) {
                    unsigned lo = 0u, hi = 0u;
                    lo = __builtin_amdgcn_cvt_pk_fp8_f32(o[0], o[1], lo, false); lo = __builtin_amdgcn_cvt_pk_fp8_f32(o[2], o[3], lo, true);
                    hi = __builtin_amdgcn_cvt_pk_fp8_f32(o[4], o[5], hi, false); hi = __builtin_amdgcn_cvt_pk_fp8_f32(o[6], o[7], hi, true);
                    *(u32x2*)((unsigned char*)G + (size_t)row * DFF + col0) = (u32x2){lo, hi};
                } else {
                    u32x4 w; w.x = cvt_pk_bf16(o[0], o[1]); w.y = cvt_pk_bf16(o[2], o[3]); w.z = cvt_pk_bf16(o[4], o[5]); w.w = cvt_pk_bf16(o[6], o[7]);
                    *(u32x4*)(G + (size_t)row * DFF + col0) = w;
                }
            }
        return false;
    }
};
template <bool RES16, bool OUT32, bool OUT16, bool OUT8, bool SS> struct EpiRes {
    const void* res; float* out; bf16_t* ob; float* ss; unsigned char* ob8; float alpha;
    __device__ __forceinline__ bool operator()(f32x4 (&acc)[2][2][4][2], const Unit& u, int wr, int wc, int fr, int fq) const {
        const int row0 = u.pm * 256 + wr * 64 + fr, col0 = u.pn * 256 + wc * 32 + 8 * fq;
        constexpr int MB = 2;
#pragma unroll
        for (int ai = 0; ai < 2; ++ai)
#pragma unroll
          for (int mb = 0; mb < 4; mb += MB) {
            f32x4 rr[MB][2][2]; u32x4 rh[MB][2];
#pragma unroll
            for (int m = 0; m < MB; ++m) { const size_t off = (size_t)(row0 + ai * 128 + (mb + m) * 16) * DM + col0;
#pragma unroll
                for (int bj = 0; bj < 2; ++bj) {
                    if constexpr (RES16) rh[m][bj] = *(const u32x4*)((const bf16_t*)res + off + bj * 128);
                    else { rr[m][bj][0] = *(const f32x4*)((const float*)res + off + bj * 128); rr[m][bj][1] = *(const f32x4*)((const float*)res + off + bj * 128 + 4); } } }
#pragma unroll
            for (int mm = 0; mm < MB; ++mm) {
                const int m = mb + mm;
                const int row = row0 + ai * 128 + m * 16; const size_t off = (size_t)row * DM + col0; float sq = 0.f;
#pragma unroll
                for (int bj = 0; bj < 2; ++bj) {
                    f32x4 r0, r1;
                    if constexpr (RES16) { const u32x4 h = rh[mm][bj]; r0 = (f32x4){bf_lo(h.x), bf_hi(h.x), bf_lo(h.y), bf_hi(h.y)}; r1 = (f32x4){bf_lo(h.z), bf_hi(h.z), bf_lo(h.w), bf_hi(h.w)}; }
                    else { r0 = rr[mm][bj][0]; r1 = rr[mm][bj][1]; }
                    const f32x4 o0 = r0 + acc[ai][bj][m][0] * alpha, o1 = r1 + acc[ai][bj][m][1] * alpha;
                    if constexpr (OUT32) { *(f32x4*)(out + off + bj * 128) = o0; *(f32x4*)(out + off + bj * 128 + 4) = o1; }
                    if constexpr (OUT16) { u32x4 w; w.x = cvt_pk_bf16(o0[0], o0[1]); w.y = cvt_pk_bf16(o0[2], o0[3]); w.z = cvt_pk_bf16(o1[0], o1[1]); w.w = cvt_pk_bf16(o1[2], o1[3]);
                        *(u32x4*)(ob + off + bj * 128) = w; }
                    if constexpr (SS) sq += (o0[0] * o0[0] + o0[1] * o0[1]) + (o0[2] * o0[2] + o0[3] * o0[3]) + (o1[0] * o1[0] + o1[1] * o1[1]) + (o1[2] * o1[2] + o1[3] * o1[3]);
                    if constexpr (OUT8) {
                        unsigned lo = 0u, hi = 0u;
                        lo = __builtin_amdgcn_cvt_pk_fp8_f32(o0[0] * H8_SCALE, o0[1] * H8_SCALE, lo, false); lo = __builtin_amdgcn_cvt_pk_fp8_f32(o0[2] * H8_SCALE, o0[3] * H8_SCALE, lo, true);
                        hi = __builtin_amdgcn_cvt_pk_fp8_f32(o1[0] * H8_SCALE, o1[1] * H8_SCALE, hi, false); hi = __builtin_amdgcn_cvt_pk_fp8_f32(o1[2] * H8_SCALE, o1[3] * H8_SCALE, hi, true);
                        *(u32x2*)(ob8 + off + bj * 128) = (u32x2){lo, hi};
                    }
                }
                if constexpr (SS) { sq += __shfl_xor(sq, 16); sq += __shfl_xor(sq, 32); if (fq == 0) ss[(size_t)row * 64 + u.pn * 4 + wc] = sq; }
            }
          }
        return false;
    }
};
template <int PART> struct EpiIn {
    const LAS float* rsl; bf16_t* U; bf16_t* V; bf16_t* Qr; bf16_t* QIr; float* KVr; unsigned char* gates; const float* gbias; float* ssv;
    __device__ __forceinline__ bool operator()(f32x4 (&acc)[2][2][4][2], const Unit& u, int wr, int wc, int fr, int fq) const {
        const int row0 = u.pm * 256 + wr * 64 + fr, c8 = wc * 32 + 8 * fq; const int pp = u.pn;
        const int pn = PART == 0 ? (pp < 16 ? pp : pp < 24 ? pp + 8 : pp + 8) : (pp < 8 ? 16 + pp : pp + 42);
        float rsv[2][4];
#pragma unroll
        for (int ai = 0; ai < 2; ++ai)
#pragma unroll
            for (int m = 0; m < 4; ++m) rsv[ai][m] = rsl[ai * 128 + wr * 64 + m * 16 + fr];
        f32x4 gbv[2][2];
        if (pn >= 34) { const int gc = (pn - 34) * 256 + c8;
#pragma unroll
            for (int bj = 0; bj < 2; ++bj) { gbv[bj][0] = *(const f32x4*)(gbias + gc + bj * 128) * (-LOG2E); gbv[bj][1] = *(const f32x4*)(gbias + gc + bj * 128 + 4) * (-LOG2E); } }
        else {
#pragma unroll
            for (int bj = 0; bj < 2; ++bj) { gbv[bj][0] = (f32x4){0.f, 0.f, 0.f, 0.f}; gbv[bj][1] = (f32x4){0.f, 0.f, 0.f, 0.f}; } }
#pragma unroll
        for (int ai = 0; ai < 2; ++ai)
#pragma unroll
            for (int m = 0; m < 4; ++m) {
                const int row = row0 + ai * 128 + m * 16;
                const float rs = (PART == 0 ? 1.0f : 1.0f / (H8_SCALE * WIN8_SCALE)) * rsv[ai][m];
                const float c1 = -LOG2E * rs;
                f32x4 v[2][2];
#pragma unroll
                for (int bj = 0; bj < 2; ++bj)
#pragma unroll
                    for (int n = 0; n < 2; ++n) v[bj][n] = acc[ai][bj][m][n] * rs;
                if (pn < 16) {
                    bf16_t* dst = (pn < 8 ? U : V) + (size_t)row * GW + (pn & 7) * 256 + c8; float sq = 0.f;
#pragma unroll
                    for (int bj = 0; bj < 2; ++bj) {
                        const f32x4 g0 = gelu4(v[bj][0]), g1 = gelu4(v[bj][1]);
                        u32x4 w; w.x = cvt_pk_bf16(g0[0], g0[1]); w.y = cvt_pk_bf16(g0[2], g0[3]); w.z = cvt_pk_bf16(g1[0], g1[1]); w.w = cvt_pk_bf16(g1[2], g1[3]);
                        *(u32x4*)(dst + bj * 128) = w;
                        sq += (g0[0] * g0[0] + g0[1] * g0[1]) + (g0[2] * g0[2] + g0[3] * g0[3]) + (g1[0] * g1[0] + g1[1] * g1[1]) + (g1[2] * g1[2] + g1[3] * g1[3]);
                    }
                    if (pn >= 8) { sq += __shfl_xor(sq, 16); sq += __shfl_xor(sq, 32); if (fq == 0) ssv[(size_t)row * 32 + (pn - 8) * 4 + wc] = sq; }
                } else if (pn < 32) {
                    bf16_t* dst = (pn < 24 ? Qr : QIr) + (size_t)row * 2048 + (pn & 7) * 256 + c8;
#pragma unroll
                    for (int bj = 0; bj < 2; ++bj) {
                        u32x4 w; w.x = cvt_pk_bf16(v[bj][0][0], v[bj][0][1]); w.y = cvt_pk_bf16(v[bj][0][2], v[bj][0][3]); w.z = cvt_pk_bf16(v[bj][1][0], v[bj][1][1]); w.w = cvt_pk_bf16(v[bj][1][2], v[bj][1][3]);
                        *(u32x4*)(dst + bj * 128) = w;
                    }
                } else if (pn < 34) {
                    float* dst = KVr + (size_t)row * KVW + (pn - 32) * 256 + c8;
#pragma unroll
                    for (int bj = 0; bj < 2; ++bj)
                        if (pn == 32 || (bj == 0 && wc < 3)) { *(f32x4*)(dst + bj * 128) = v[bj][0]; *(f32x4*)(dst + bj * 128 + 4) = v[bj][1]; }
                } else {
                    unsigned char* dst = gates + (size_t)row * NGATE + (pn - 34) * 256 + c8;
#pragma unroll
                    for (int bj = 0; bj < 2; ++bj) {
                        unsigned q[8];
#pragma unroll
                        for (int j = 0; j < 4; ++j) {
                            constexpr float IC = 1.0f / 255.996f;
                            const float g0 = __builtin_amdgcn_rcpf(__builtin_amdgcn_exp2f(acc[ai][bj][m][0][j] * c1 + gbv[bj][0][j]) * IC + IC);
                            const float g1 = __builtin_amdgcn_rcpf(__builtin_amdgcn_exp2f(acc[ai][bj][m][1][j] * c1 + gbv[bj][1][j]) * IC + IC);
                            q[j] = (unsigned)g0; q[4 + j] = (unsigned)g1; }
                        const u32x2 w = (u32x2){q[0] | (q[1] << 8) | (q[2] << 16) | (q[3] << 24), q[4] | (q[5] << 8) | (q[6] << 16) | (q[7] << 24)};
                        *(u32x2*)(dst + bj * 128) = w;
                    }
                }
            }
        return false;
    }
};
struct EpiMerge {
    const unsigned char* gates; bf16_t* Mb;
    __device__ __forceinline__ bool operator()(f32x4 (&acc)[2][2][4][2], const Unit& u, int wr, int wc, int fr, int fq) const {
        const int row0 = u.pm * 256 + wr * 64 + fr, col0 = u.pn * 256 + wc * 32 + 8 * fq;
#pragma unroll
        for (int ai = 0; ai < 2; ++ai) {
            u32x2 gbr[4][2], gar[4][2];
#pragma unroll
            for (int m = 0; m < 4; ++m)
#pragma unroll
                for (int bj = 0; bj < 2; ++bj) { const unsigned char* gp = gates + (size_t)(row0 + ai * 128 + m * 16) * NGATE + col0 + bj * 128;
                    gbr[m][bj] = *(const u32x2*)(gp + DM); gar[m][bj] = (u.seg == 0) ? *(const u32x2*)gp : (u32x2){0u, 0u}; }
#pragma unroll
            for (int m = 0; m < 4; ++m) {
                const int row = row0 + ai * 128 + m * 16;
#pragma unroll
                for (int bj = 0; bj < 2; ++bj) {
                    const int col = col0 + bj * 128;
                    const u32x2 gb = gbr[m][bj];
                    float fb[8];
#pragma unroll
                    for (int j = 0; j < 4; ++j) { fb[j] = (float)((gb.x >> (8 * j)) & 255u) + 0.5f; fb[4 + j] = (float)((gb.y >> (8 * j)) & 255u) + 0.5f; }
                    if (u.seg == 0) {
                        const u32x2 ga = gar[m][bj];
#pragma unroll
                        for (int j = 0; j < 4; ++j) {
                            const float a0 = (float)((ga.x >> (8 * j)) & 255u) + 0.5f, a1 = (float)((ga.y >> (8 * j)) & 255u) + 0.5f;
                            acc[ai][bj][m][0][j] *= a0 * __builtin_amdgcn_rcpf(fb[j]); acc[ai][bj][m][1][j] *= a1 * __builtin_amdgcn_rcpf(fb[4 + j]); }
                    } else {
                        float o[8];
#pragma unroll
                        for (int j = 0; j < 4; ++j) { o[j] = acc[ai][bj][m][0][j] * (fb[j] * (1.0f / 256.0f)); o[4 + j] = acc[ai][bj][m][1][j] * (fb[4 + j] * (1.0f / 256.0f)); }
                        u32x4 w; w.x = cvt_pk_bf16(o[0], o[1]); w.y = cvt_pk_bf16(o[2], o[3]); w.z = cvt_pk_bf16(o[4], o[5]); w.w = cvt_pk_bf16(o[6], o[7]);
                        *(u32x4*)(Mb + (size_t)row * DM + col) = w;
                    }
                }
            }
        }
        return u.seg == 0;
    }
};

struct Params { const float* in[21]; float* out; unsigned char* ws; int ph_lo, ph_hi; };
enum In { I_X = 0, I_F1N, I_F1W1, I_F1W3, I_F1W2, I_MIXN, I_WIN, I_GBIAS, I_VNORM, I_GWS, I_GBS, I_QN, I_KN, I_IKN, I_WBA, I_WBB, I_WOUT, I_F2N, I_F2W1, I_F2W3, I_F2W2 };

struct ConvD { const float* src; const float* gain; unsigned char* dst; int N; int pitch; int mode; float sc; };
__device__ __forceinline__ ConvD conv_desc(const Params& p, int it) {
    unsigned char* ws = p.ws; ConvD d; d.gain = nullptr; d.sc = 1.0f; d.mode = 1;
    constexpr int I_W13 = (DM / 64) * (2 * DFF / 32), I_W2 = (DFF / 64) * (DM / 32), I_WINI = (DM / 64) * (NIN / 32), I_WAB = (GW / 64) * (DM / 32);
    int r = it;
    if (r < 2 * I_W13) {
        const int second = r >= I_W13; if (second) r -= I_W13;
        constexpr int nrb = 2 * DFF / 32; const int kb = r / nrb, rb = r % nrb, r0 = 32 * rb, pn = r0 >> 8, rr = r0 & 255, k0 = 64 * kb;
        const float* w = second ? (rr < 128 ? p.in[I_F2W1] : p.in[I_F2W3]) : (rr < 128 ? p.in[I_F1W1] : p.in[I_F1W3]);
        d.src = w + (size_t)k0 * DFF + 128 * pn + (rr & 127); d.N = DFF; d.gain = (second ? p.in[I_F2N] : p.in[I_F1N]) + k0;
        if (second && USE_FP8_UP2) { d.mode = 3; d.sc = WIN8_SCALE; d.dst = ws + WS_W13B + (size_t)r0 * DM + k0; d.pitch = DM; return d; }
        d.dst = ws + (second ? WS_W13B : WS_W13A) + ((size_t)r0 * DM + k0) * 2; d.pitch = DM * 2; return d;
    }
    r -= 2 * I_W13;
    if (r < 2 * I_W2) {
        const int second = r >= I_W2; if (second) r -= I_W2;
        constexpr int nrb = DM / 32; const int kb = r / nrb, rb = r % nrb, r0 = 32 * rb, k0 = 64 * kb;
        d.src = (second ? p.in[I_F2W2] : p.in[I_F1W2]) + (size_t)k0 * DM + r0; d.N = DM;
        if (second ? (USE_FP8_DOWN != 0) : (USE_FP8_DOWN1 != 0)) { d.mode = 2; d.sc = W8_SCALE; d.dst = ws + (second ? WS_W2B : WS_W2A) + (size_t)r0 * DFF + k0; d.pitch = DFF; }
        else { d.dst = ws + (second ? WS_W2B : WS_W2A) + ((size_t)r0 * DFF + k0) * 2; d.pitch = DFF * 2; }
        return d;
    }
    r -= 2 * I_W2;
    if (r < I_WINI) {
        constexpr int nrbA = NIN_A / 32, I_A = (DM / 64) * nrbA, nrbB = NIN_B / 32;
        const bool partB = r >= I_A; if (partB) r -= I_A;
        const int nrb = partB ? nrbB : nrbA, kb = r / nrb, rb = r % nrb, r0 = 32 * rb, k0 = 64 * kb, pt = r0 >> 8, w = r0 & 255;
        int n0;
        if (!partB) n0 = pt < 16 ? r0 : pt < 24 ? 6400 + (r0 - 4096) : pt == 24 ? 6144 + w : pt == 25 ? (w < 96 ? 8448 + w : -1) : 8544 + (pt - 26) * 256 + w;
        else        n0 = pt < 8 ? 4096 + r0 : 12640 + (pt - 8) * 256 + w;
        d.src = p.in[I_WIN] + (size_t)k0 * 16736 + (n0 < 0 ? 0 : n0); d.N = 16736; d.gain = p.in[I_MIXN] + k0; if (n0 < 0) d.mode = 0;
        if (partB) { d.mode = 3; d.sc = WIN8_SCALE; d.dst = ws + WS_WINB8 + (size_t)r0 * DM + k0; d.pitch = DM; }
        else { d.dst = ws + WS_WIN + ((size_t)r0 * DM + k0) * 2; d.pitch = DM * 2; }
        return d;
    }
    r -= I_WINI;
    if (r < 2 * I_WAB) {
        const int second = r >= I_WAB; if (second) r -= I_WAB;
        constexpr int nrb = DM / 32; const int kb = r / nrb, rb = r % nrb, r0 = 32 * rb, k0 = 64 * kb;
        d.src = (second ? p.in[I_WBB] : p.in[I_WBA]) + (size_t)k0 * DM + r0; d.N = DM;
        d.dst = ws + (second ? WS_WB : WS_WA) + ((size_t)r0 * GW + k0) * 2; d.pitch = GW * 2; return d;
    }
    r -= 2 * I_WAB;
    { constexpr int nrb = DM / 32; const int kb = r / nrb, rb = r % nrb, r0 = 32 * rb, k0 = 64 * kb;
      d.src = p.in[I_WOUT] + (size_t)k0 * DM + r0; d.N = DM; d.dst = ws + WS_WOUT + ((size_t)r0 * DM + k0) * 2; d.pitch = DM * 2; return d; }
}
__device__ __forceinline__ void conv_load(const ConvD& d, f32x4 (&v)[8], int lane) {
    if (d.mode == 0) return;
#pragma unroll
    for (int i = 0; i < 8; ++i) v[i] = *(const f32x4*)(d.src + (size_t)(8 * i + (lane >> 3)) * d.N + 4 * (lane & 7));
}
__device__ __forceinline__ void conv_finish(const ConvD& d, const f32x4 (&v)[8], LAS float* scr, int lane) {
    if (d.mode == 0) {
#pragma unroll
        for (int j = 0; j < 4; ++j) { const int q = lane + 64 * j; *(u32x4*)(d.dst + (size_t)(q >> 3) * d.pitch + 16 * (q & 7)) = (u32x4){0u, 0u, 0u, 0u}; }
        return;
    }
#pragma unroll
    for (int i = 0; i < 8; ++i) { const int kk = 8 * i + (lane >> 3); const float gn = d.gain ? d.gain[kk] * d.sc : d.sc; LAS float* s = scr + kk * 33 + 4 * (lane & 7);
        s[0] = v[i][0] * gn; s[1] = v[i][1] * gn; s[2] = v[i][2] * gn; s[3] = v[i][3] * gn; }
    asm volatile("s_waitcnt lgkmcnt(0)" ::: "memory");
    const int c = lane & 7;
#pragma unroll
    for (int j = 0; j < 4; ++j) { const int n = (lane >> 3) + 8 * j; const LAS float* s = scr + (8 * c) * 33 + n;
        if (d.mode >= 2) {
            unsigned lo = 0u, hi = 0u;
            lo = __builtin_amdgcn_cvt_pk_fp8_f32(s[0 * 33], s[1 * 33], lo, false); lo = __builtin_amdgcn_cvt_pk_fp8_f32(s[2 * 33], s[3 * 33], lo, true);
            hi = __builtin_amdgcn_cvt_pk_fp8_f32(s[4 * 33], s[5 * 33], hi, false); hi = __builtin_amdgcn_cvt_pk_fp8_f32(s[6 * 33], s[7 * 33], hi, true);
            *(u32x2*)(d.dst + (size_t)n * d.pitch + 8 * c) = (u32x2){lo, hi};
        } else {
            u32x4 o; o.x = cvt_pk_bf16(s[0 * 33], s[1 * 33]); o.y = cvt_pk_bf16(s[2 * 33], s[3 * 33]); o.z = cvt_pk_bf16(s[4 * 33], s[5 * 33]); o.w = cvt_pk_bf16(s[6 * 33], s[7 * 33]);
            *(u32x4*)(d.dst + (size_t)n * d.pitch + 16 * c) = o;
        } }
    asm volatile("s_waitcnt lgkmcnt(0)" ::: "memory");
}
__device__ __forceinline__ void conv_items(const Params& p, LAS float* scr, int first, int stride, int count, int skip_at, int skip_n, int lane, int skip2_at = 0x7fffffff, int skip2_n = 0) {
    if (first >= count) return;
    auto idx = [&](int i) { const int j = i < skip_at ? i : i + skip_n; return j < skip2_at ? j : j + skip2_n; };
    ConvD d = conv_desc(p, idx(first)); f32x4 v[8]; conv_load(d, v, lane);
    for (int it = first; it < count; it += stride) {
        const bool has = it + stride < count; ConvD dn = d; f32x4 vn[8];
        if (has) { dn = conv_desc(p, idx(it + stride)); conv_load(dn, vn, lane); }
        conv_finish(d, v, scr, lane);
        if (has) { d = dn;
#pragma unroll
            for (int i = 0; i < 8; ++i) v[i] = vn[i]; }
    }
}
__device__ __forceinline__ void phase_prologue(const Params& p, LAS unsigned char* lds, int tid, int lane, int wave) {
    unsigned char* ws = p.ws;
    const int gw = (int)blockIdx.x * 8 + wave, NGW = (int)gridDim.x * 8;
    LAS float* scr = (LAS float*)(lds + wave * 16384);
    constexpr int I_W13 = (DM / 64) * (2 * DFF / 32), I_W2 = (DFF / 64) * (DM / 32), I_WINI = (DM / 64) * (NIN / 32), I_WAB = (GW / 64) * (DM / 32), I_WO = (DM / 64) * (DM / 32);
    constexpr int NITEMS = 2 * I_W13 + 2 * I_W2 + I_WINI + 2 * I_WAB + I_WO;
    conv_items(p, scr, gw, NGW, NITEMS - I_W2 - I_W2 / 2, 2 * I_W13, I_W2, lane, 2 * I_W13 + I_W2 + I_W2 / 2, I_W2 / 2);
    { const float* x = p.in[I_X]; bf16_t* xb = (bf16_t*)(ws + WS_R1);
      for (int row = gw; row < MROWS; row += NGW) {
          const f32x4* xr = (const f32x4*)(x + (size_t)row * DM) + lane; f32x4 v[16]; float s = 0.f;
#pragma unroll
          for (int j = 0; j < 16; ++j) { v[j] = xr[64 * j]; s += (v[j][0] * v[j][0] + v[j][1] * v[j][1]) + (v[j][2] * v[j][2] + v[j][3] * v[j][3]); }
          const float rs = 1.0f / sqrtf(wave_sum(s) * (1.0f / DM) + EPS);
          u32x2* o = (u32x2*)(xb + (size_t)row * DM) + lane;
#pragma unroll
          for (int j = 0; j < 16; ++j) { u32x2 w; w.x = cvt_pk_bf16(v[j][0] * rs, v[j][1] * rs); w.y = cvt_pk_bf16(v[j][2] * rs, v[j][3] * rs); o[64 * j] = w; }
      } }
    { const int gt = (int)blockIdx.x * 512 + tid, NT = (int)gridDim.x * 512;
      float* cosA = (float*)(ws + WS_COSA); float* sinA = (float*)(ws + WS_SINA); float* cosI = (float*)(ws + WS_COSI); float* sinI = (float*)(ws + WS_SINI);
      for (int i = gt; i < SEQ * 64; i += NT) { const int pos = i >> 6, f = i & 63; const float inv = powf(10000.0f, -(float)(2 * f) / 128.0f); const float ang = (float)pos * inv; cosA[i] = cosf(ang); sinA[i] = sinf(ang); }
      for (int i = gt; i < SEQ * 32; i += NT) { const int pos = i >> 5, f = i & 31; const float inv = powf(10000.0f, -(float)(2 * f) / 64.0f); const float ang = (float)pos * inv; cosI[i] = cosf(ang); sinI[i] = sinf(ang); }
      bf16_t* w16 = (bf16_t*)(ws + WS_WS16); const float* gws = p.in[I_GWS];
      for (int i = gt; i < 16 * 128 * 128 / 2; i += NT) { const int e = 2 * i, t = (e >> 7) & 127, s = e & 127; const float a = gws[e], b = gws[e + 1]; const bool z = (t < 64 && s >= 64);
          ((unsigned*)w16)[i] = z ? 0u : cvt_pk_bf16(a, b); }
    }
}

__device__ __forceinline__ void panel_rs(const float* ssp, int pm, LAS float* rsl, int tid) {
    const int r = tid >> 1, hf = tid & 1; const f32x4* pp = (const f32x4*)(ssp + (size_t)(pm * 256 + r) * 64 + hf * 32);
    f32x4 a[8];
#pragma unroll
    for (int i = 0; i < 8; ++i) a[i] = pp[i];
    float s = 0.f;
#pragma unroll
    for (int i = 0; i < 8; ++i) s += (a[i][0] + a[i][1]) + (a[i][2] + a[i][3]);
    s += __shfl_xor(s, 1);
    if (hf == 0) rsl[r] = 1.0f / sqrtf(s * (1.0f / DM) + EPS);
    __syncthreads();
}
__device__ __forceinline__ void phase_post(const Params& p, int lane, int wave) {
    unsigned char* ws = p.ws;
    const int gw = (int)blockIdx.x * 8 + wave, NGW = (int)gridDim.x * 8;
    const float* KVr = (const float*)(ws + WS_KVR); bf16_t* Kn = (bf16_t*)(ws + WS_KN); bf16_t* Vb = (bf16_t*)(ws + WS_VB); bf16_t* KIn = (bf16_t*)(ws + WS_KIN); float* WI = (float*)(ws + WS_WI);
    const float* cosA = (const float*)(ws + WS_COSA); const float* sinA = (const float*)(ws + WS_SINA); const float* cosI = (const float*)(ws + WS_COSI); const float* sinI = (const float*)(ws + WS_SINI);
    const float* kn = p.in[I_KN]; const float* ikn = p.in[I_IKN];
    const float g1 = kn[lane], g2 = kn[64 + lane]; const float ig1 = ikn[lane & 31], ig2 = ikn[32 + (lane & 31)];
    const float* ssvp = (const float*)(ws + WS_SSVP); float* ssvo = (float*)(ws + CTL_SSV);
    for (int row2 = gw; row2 < MROWS; row2 += 2 * NGW)
#pragma unroll
      for (int rq = 0; rq < 2; ++rq) { const int row = row2 + rq * NGW; if (row < MROWS) {
        { const float pv = wave_sum(lane < 32 ? ssvp[(size_t)row * 32 + lane] : 0.f); if (lane == 0) ssvo[row] = pv; }
        const float* kv = KVr + (size_t)row * KVW; const int pos = row & (SEQ - 1);
        { const float x1 = kv[lane], x2 = kv[64 + lane]; const float rs = 1.0f / sqrtf(wave_sum(x1 * x1 + x2 * x2) * (1.0f / 128.0f) + EPS);
          const float y1 = x1 * rs * g1, y2 = x2 * rs * g2, c = cosA[pos * 64 + lane], s = sinA[pos * 64 + lane];
          Kn[(size_t)row * 128 + lane] = (bf16_t)(cvt_pk_bf16(y1 * c - y2 * s, 0.f) & 0xffffu); Kn[(size_t)row * 128 + 64 + lane] = (bf16_t)(cvt_pk_bf16(y1 * s + y2 * c, 0.f) & 0xffffu); }
        { const float a = kv[128 + 2 * lane], b = kv[129 + 2 * lane]; ((unsigned*)(Vb + (size_t)row * 128))[lane] = cvt_pk_bf16(a, b); }
        { const int l = lane & 31; const float x1 = kv[256 + l], x2 = kv[288 + l]; const float rs = 1.0f / sqrtf(wave_sum(lane < 32 ? x1 * x1 + x2 * x2 : 0.f) * (1.0f / 64.0f) + EPS);
          const float y1 = x1 * rs * ig1, y2 = x2 * rs * ig2, c = cosI[pos * 32 + l], s = sinI[pos * 32 + l];
          if (lane < 32) { KIn[(size_t)row * 64 + l] = (bf16_t)(cvt_pk_bf16(y1 * c - y2 * s, 0.f) & 0xffffu); KIn[(size_t)row * 64 + 32 + l] = (bf16_t)(cvt_pk_bf16(y1 * s + y2 * c, 0.f) & 0xffffu);
                           WI[(size_t)row * 32 + l] = kv[320 + l] * IDX_SCALE; } }
      } }
}

typedef short s16x4 __attribute__((ext_vector_type(4)));
constexpr int VROW = 288;
struct GmlpSet { u32x4 raw[4]; float ssn[4]; u32x2 ur[8]; };
__device__ __forceinline__ void gmlp_units(const Params& p, LAS unsigned char* lds, int G, int tid, int lane, int wave) {
    unsigned char* ws = p.ws;
    const bf16_t* Vg = (const bf16_t*)(ws + WS_V); const bf16_t* U = (const bf16_t*)(ws + WS_U); bf16_t* Ya = (bf16_t*)(ws + WS_YA);
    const float* ssv = (const float*)(ws + CTL_SSV);
    const int n = lane & 15, g4 = lane >> 4, tl = 16 * wave + n;
    const int u0 = (int)blockIdx.x;
    if (u0 >= 2048) return;
    const int nun = (2048 - u0 + G - 1) / G, ulast = u0 + (nun - 1) * G;
    const int srow = tid >> 4, scc = tid & 15;
    const unsigned stoff = (unsigned)(srow * VROW + scc * 16), tboff = (unsigned)((4 * g4 + (n >> 2)) * VROW + 8 * (n & 3));
    GmlpSet S0, S1;
    bf16x8 bw[4]; f32x4 gnv[8]; float bsv; int gcur = -1;
#define GM_LOAD_V(S, un) do { const int un_ = (un) < ulast ? (un) : ulast; const int r0_ = (un_ >> 4) * 128, c0_ = (un_ & 15) * 128; \
        _Pragma("unroll") for (int i = 0; i < 4; ++i) { S.raw[i] = *(const u32x4*)(Vg + (size_t)(r0_ + srow + 32 * i) * GW + c0_ + 8 * scc); S.ssn[i] = ssv[r0_ + srow + 32 * i]; } } while (0)
#define GM_LOAD_U(S, un) do { const int un_ = (un) < ulast ? (un) : ulast; const int r0_ = (un_ >> 4) * 128, c0_ = (un_ & 15) * 128; \
        _Pragma("unroll") for (int tn = 0; tn < 8; ++tn) S.ur[tn] = *(const u32x2*)(U + (size_t)(r0_ + tl) * GW + c0_ + 16 * tn + 4 * g4); } while (0)
#define GM_BODY(S, tileoff, unit) do { \
        const int g = (unit) & 15, r0 = ((unit) >> 4) * 128, c0 = g * 128; \
        LAS unsigned char* tile = lds + (tileoff); \
        _Pragma("unroll") for (int i = 0; i < 4; ++i) { \
            const float rs = __builtin_amdgcn_rsqf(S.ssn[i] * (1.0f / GW) + EPS); \
            const unsigned wv_[4] = {S.raw[i].x, S.raw[i].y, S.raw[i].z, S.raw[i].w}; u32x4 o_; \
            o_.x = cvt_pk_bf16(bf_lo(wv_[0]) * rs, bf_hi(wv_[0]) * rs); o_.y = cvt_pk_bf16(bf_lo(wv_[1]) * rs, bf_hi(wv_[1]) * rs); \
            o_.z = cvt_pk_bf16(bf_lo(wv_[2]) * rs, bf_hi(wv_[2]) * rs); o_.w = cvt_pk_bf16(bf_lo(wv_[3]) * rs, bf_hi(wv_[3]) * rs); \
            *(LAS u32x4*)(tile + stoff + i * 32 * VROW) = o_; } \
        __syncthreads(); \
        GM_LOAD_V(S, (unit) + 2 * G); \
        if (g != gcur) { gcur = g; const bf16_t* w16 = (const bf16_t*)(ws + WS_WS16) + (size_t)g * 128 * 128 + (size_t)tl * 128 + 4 * g4; \
            _Pragma("unroll") for (int ks = 0; ks < 4; ++ks) { const u32x2 lo_ = *(const u32x2*)(w16 + 32 * ks), hi_ = *(const u32x2*)(w16 + 32 * ks + 16); \
                const u32x4 w_ = (u32x4){lo_.x, lo_.y, hi_.x, hi_.y}; bw[ks] = __builtin_bit_cast(bf16x8, w_); } \
            bsv = p.in[I_GBS][g * 128 + tl]; \
            _Pragma("unroll") for (int tn = 0; tn < 8; ++tn) gnv[tn] = *(const f32x4*)(p.in[I_VNORM] + c0 + 16 * tn + 4 * g4); } \
        const size_t rowoff = (size_t)(r0 + tl) * GW + c0; \
        _Pragma("unroll") for (int tn = 0; tn < 8; ++tn) { \
            f32x4 acc = (f32x4){0.f, 0.f, 0.f, 0.f}; \
            _Pragma("unroll") for (int ks = 0; ks < 4; ++ks) { \
                const s16x4 t0_ = __builtin_amdgcn_ds_read_tr16_b64_v4i16((LAS s16x4*)(tile + tboff + ks * 32 * VROW + tn * 32)); \
                const s16x4 t1_ = __builtin_amdgcn_ds_read_tr16_b64_v4i16((LAS s16x4*)(tile + tboff + ks * 32 * VROW + 16 * VROW + tn * 32)); \
                const bf16x8 av = (bf16x8){t0_[0], t0_[1], t0_[2], t0_[3], t1_[0], t1_[1], t1_[2], t1_[3]}; \
                acc = __builtin_amdgcn_mfma_f32_16x16x32_bf16(av, bw[ks], acc, 0, 0, 0); } \
            const int cl = 16 * tn + 4 * g4;                                     \
            const f32x4 gn = gnv[tn]; \
            const float uu[4] = {bf_lo(S.ur[tn].x), bf_hi(S.ur[tn].x), bf_lo(S.ur[tn].y), bf_hi(S.ur[tn].y)}; float o[4]; \
            _Pragma("unroll") for (int r = 0; r < 4; ++r) o[r] = uu[r] * (acc[r] * gn[r] + bsv); \
            u32x2 w; w.x = cvt_pk_bf16(o[0], o[1]); w.y = cvt_pk_bf16(o[2], o[3]); \
            *(u32x2*)(Ya + rowoff + cl) = w; } \
        GM_LOAD_U(S, (unit) + 2 * G); } while (0)
    GM_LOAD_V(S0, u0); GM_LOAD_U(S0, u0); GM_LOAD_V(S1, u0 + G); GM_LOAD_U(S1, u0 + G);
    for (int unit = u0; unit <= ulast; unit += 2 * G) {
        GM_BODY(S0, 0, unit);
        if (unit + G <= ulast) GM_BODY(S1, 128 * VROW, unit + G);
    }
    __syncthreads();
#undef GM_LOAD_V
#undef GM_LOAD_U
#undef GM_BODY
}

constexpr int VCH = 32 * VROW;
static_assert(8 * 2 * VCH <= LDS_SEL, "V chunk buffers overlay the score rows and the key stage, not the selection lists");
__device__ __forceinline__ unsigned sortable_key(float s) { const unsigned b = __float_as_uint(s); return b ^ (((unsigned)((int)b >> 31)) | 0x80000000u); }
__device__ __forceinline__ void dsa_unit(const Params& p, LAS unsigned char* lds, int b, int c8, int tid, int lane, int wave) {
    unsigned char* ws = p.ws;
    const int t0 = c8 * 8, kend = 64 * ((t0 >> 6) + 1), tok = t0 + wave; const size_t row = (size_t)b * SEQ + tok;
    LAS unsigned* sc = (LAS unsigned*)(lds + LDS_SC) + wave * 4096;
    LAS unsigned short* sel = (LAS unsigned short*)(lds + LDS_SEL) + wave * 256;
    int nsel = 0;
    if (kend <= 256) {
        nsel = kend;
#pragma unroll
        for (int i = 0; i < 4; ++i) sel[lane + 64 * i] = (unsigned short)(lane + 64 * i);
    } else {
        nsel = 256;
        bf16x8 qa[4]; float wv[16];
        { const bf16_t* qp = (const bf16_t*)(ws + WS_QIR) + row * 2048 + (lane & 31) * 64 + 8 * (lane >> 5);
          u32x4 raw[4];
#pragma unroll
          for (int ks = 0; ks < 4; ++ks) raw[ks] = *(const u32x4*)(qp + 16 * ks);
          const float* cp = (const float*)(ws + WS_COSI) + tok * 32 + 8 * (lane >> 5); const float* sp = (const float*)(ws + WS_SINI) + tok * 32 + 8 * (lane >> 5);
#pragma unroll
          for (int ks = 0; ks < 2; ++ks) {
              const f32x4 c0 = *(const f32x4*)(cp + 16 * ks), c1 = *(const f32x4*)(cp + 16 * ks + 4), s0 = *(const f32x4*)(sp + 16 * ks), s1 = *(const f32x4*)(sp + 16 * ks + 4);
              const float cc[8] = {c0[0], c0[1], c0[2], c0[3], c1[0], c1[1], c1[2], c1[3]}, ss[8] = {s0[0], s0[1], s0[2], s0[3], s1[0], s1[1], s1[2], s1[3]};
              const unsigned w1[4] = {raw[ks].x, raw[ks].y, raw[ks].z, raw[ks].w}, w2[4] = {raw[ks + 2].x, raw[ks + 2].y, raw[ks + 2].z, raw[ks + 2].w};
              unsigned o1[4], o2[4];
#pragma unroll
              for (int e = 0; e < 4; ++e) {
                  const float a0 = bf_lo(w1[e]), a1 = bf_hi(w1[e]), b0 = bf_lo(w2[e]), b1 = bf_hi(w2[e]);
                  o1[e] = cvt_pk_bf16(a0 * cc[2 * e] - b0 * ss[2 * e], a1 * cc[2 * e + 1] - b1 * ss[2 * e + 1]);
                  o2[e] = cvt_pk_bf16(a0 * ss[2 * e] + b0 * cc[2 * e], a1 * ss[2 * e + 1] + b1 * cc[2 * e + 1]);
              }
              const u32x4 p1 = (u32x4){o1[0], o1[1], o1[2], o1[3]}, p2 = (u32x4){o2[0], o2[1], o2[2], o2[3]};
              qa[ks] = __builtin_bit_cast(bf16x8, p1); qa[ks + 2] = __builtin_bit_cast(bf16x8, p2);
          }
          const float* wp = (const float*)(ws + WS_WI) + row * 32 + 4 * (lane >> 5);
#pragma unroll
          for (int q = 0; q < 4; ++q) { const f32x4 t = *(const f32x4*)(wp + 8 * q); wv[4 * q] = t[0]; wv[4 * q + 1] = t[1]; wv[4 * q + 2] = t[2]; wv[4 * q + 3] = t[3]; }
        }
        const bf16_t* kbase = (const bf16_t*)(ws + WS_KIN) + (size_t)b * SEQ * 64;
        const int nst = kend >> 6; const int skey = tid >> 3, sch = tid & 7;
        const int lastst = nst - 1, nst4 = (nst + 3) & ~3;
        const unsigned wroff = (unsigned)(LDS_KST + skey * KPITCH + sch * 16);
        const int key0 = lane & 31, h5 = lane >> 5;
        const unsigned rdoff = (unsigned)(LDS_KST + key0 * KPITCH + h5 * 16);
        unsigned rb0 = rdoff, rb1 = rdoff + KSTG, rb2 = rdoff + 2 * KSTG;
        unsigned wb0 = wroff + 2 * KSTG, wb1 = wroff, wb2 = wroff + KSTG;
        { const u32x4 v0 = *(const u32x4*)(kbase + tid * 8), v1 = *(const u32x4*)(kbase + (size_t)(1 < lastst ? 1 : lastst) * 4096 + tid * 8);
          *(LAS u32x4*)(lds + wroff) = v0; *(LAS u32x4*)(lds + wroff + KSTG) = v1; }
        u32x4 pre[4];
#pragma unroll
        for (int q = 0; q < 4; ++q) pre[q] = *(const u32x4*)(kbase + (size_t)(q + 2 < lastst ? q + 2 : lastst) * 4096 + tid * 8);
        __syncthreads();
        bf16x8 kf[2][8]; f32x16 ac[2][2];
#pragma unroll
        for (int j = 0; j < 8; ++j) kf[0][j] = *(const LAS bf16x8*)(lds + rb0 + (j >> 2) * 32 * KPITCH + (j & 3) * 32);
#pragma unroll
        for (int r = 0; r < 16; ++r) { ac[1][0][r] = 0.f; ac[1][1][r] = 0.f; }
#define IDX_RED(P, r) do { s0.x += wv[2 * (r)] * __builtin_amdgcn_fmed3f(P[0][2 * (r)], 0.f, 3.0e38f); s1.x += wv[2 * (r)] * __builtin_amdgcn_fmed3f(P[1][2 * (r)], 0.f, 3.0e38f); \
                           s0.y += wv[2 * (r) + 1] * __builtin_amdgcn_fmed3f(P[0][2 * (r) + 1], 0.f, 3.0e38f); s1.y += wv[2 * (r) + 1] * __builtin_amdgcn_fmed3f(P[1][2 * (r) + 1], 0.f, 3.0e38f); } while (0)
#define IDX_FIN(slot) do { const float p0 = s0.x + s0.y, p1 = s1.x + s1.y; \
            const auto e0_ = __builtin_amdgcn_permlane32_swap(__float_as_uint(p0), __float_as_uint(p0), false, false);     \
            const auto e1_ = __builtin_amdgcn_permlane32_swap(__float_as_uint(p1), __float_as_uint(p1), false, false); \
            const float tot_ = (lane < 32) ? p0 + __uint_as_float(e0_[1]) : p1 + __uint_as_float(e1_[0]);                 \
            sc[(slot) * 64 + lane] = sortable_key(tot_); } while (0)
        for (int s4 = 0; s4 < nst4; s4 += 4) {
#pragma unroll
          for (int q = 0; q < 4; ++q) {
            const int s = s4 + q;
            const int e = q & 1;
            *(LAS u32x4*)(lds + wb0) = pre[q];
            { const int sn = s + 6 < lastst ? s + 6 : lastst; pre[q] = *(const u32x4*)(kbase + (size_t)sn * 4096 + tid * 8); }
            asm volatile("" ::: "memory");
            {
                struct { float x, y; } s0 = {0.f, 0.f}, s1 = {0.f, 0.f};
#pragma unroll
                for (int r = 0; r < 16; ++r) { ac[e][0][r] = 0.f; ac[e][1][r] = 0.f; }
                ac[e][0] = __builtin_amdgcn_mfma_f32_32x32x16_bf16(qa[0], kf[e][0], ac[e][0], 0, 0, 0); IDX_RED(ac[e ^ 1], 0);
                ac[e][1] = __builtin_amdgcn_mfma_f32_32x32x16_bf16(qa[0], kf[e][4], ac[e][1], 0, 0, 0); IDX_RED(ac[e ^ 1], 1);
                ac[e][0] = __builtin_amdgcn_mfma_f32_32x32x16_bf16(qa[1], kf[e][1], ac[e][0], 0, 0, 0); IDX_RED(ac[e ^ 1], 2);
                ac[e][1] = __builtin_amdgcn_mfma_f32_32x32x16_bf16(qa[1], kf[e][5], ac[e][1], 0, 0, 0); IDX_RED(ac[e ^ 1], 3);
                ac[e][0] = __builtin_amdgcn_mfma_f32_32x32x16_bf16(qa[2], kf[e][2], ac[e][0], 0, 0, 0); IDX_RED(ac[e ^ 1], 4);
                ac[e][1] = __builtin_amdgcn_mfma_f32_32x32x16_bf16(qa[2], kf[e][6], ac[e][1], 0, 0, 0); IDX_RED(ac[e ^ 1], 5);
                ac[e][0] = __builtin_amdgcn_mfma_f32_32x32x16_bf16(qa[3], kf[e][3], ac[e][0], 0, 0, 0); IDX_RED(ac[e ^ 1], 6);
                ac[e][1] = __builtin_amdgcn_mfma_f32_32x32x16_bf16(qa[3], kf[e][7], ac[e][1], 0, 0, 0); IDX_RED(ac[e ^ 1], 7);
                IDX_FIN(s > 0 ? s - 1 : 0);
            }
            asm volatile("" ::: "memory");
            __builtin_amdgcn_sched_barrier(0);
#pragma unroll
            for (int j = 0; j < 8; ++j) kf[e ^ 1][j] = *(const LAS bf16x8*)(lds + rb1 + (j >> 2) * 32 * KPITCH + (j & 3) * 32);
            asm volatile("s_waitcnt lgkmcnt(8)" ::: "memory");
            __builtin_amdgcn_s_barrier();
            asm volatile("" ::: "memory");
            __builtin_amdgcn_sched_barrier(0);
            { const unsigned t = rb0; rb0 = rb1; rb1 = rb2; rb2 = t; const unsigned u = wb0; wb0 = wb1; wb1 = wb2; wb2 = u; }
          }
        }
        { struct { float x, y; } s0 = {0.f, 0.f}, s1 = {0.f, 0.f};
#pragma unroll
          for (int r = 0; r < 8; ++r) IDX_RED(ac[1], r);
          IDX_FIN(nst4 - 1); }
        asm volatile("s_waitcnt lgkmcnt(0)" ::: "memory");
        __syncthreads();
#undef IDX_RED
#undef IDX_FIN
        const int n64 = kend >> 6; unsigned prefix = 0u; int need = 256;
        LAS unsigned* hist = (LAS unsigned*)(lds + LDS_KST) + wave * 512;
        LAS unsigned* myh = hist + (lane >> 5) * 256;
        unsigned kr[64];
#pragma unroll
        for (int i = 0; i < 64; ++i) kr[i] = (i < n64) ? sc[64 * i + lane] : 0u;
        int sfin = 0, ncand = 0; bool done = false, fast = false;
#pragma unroll
        for (int pass = 0; pass < 4; ++pass) {
          if (!done) {
            const int shift = 24 - 8 * pass;
            *(LAS u32x4*)(hist + 4 * lane) = (u32x4){0u, 0u, 0u, 0u}; *(LAS u32x4*)(hist + 256 + 4 * lane) = (u32x4){0u, 0u, 0u, 0u};
            asm volatile("s_waitcnt lgkmcnt(0)" ::: "memory");
#pragma unroll
            for (int i = 0; i < 64; ++i) {
                if (i < n64) { const bool m = (pass == 0) || ((kr[i] >> ((shift + 8) & 31)) == prefix);
                    if (m) (void)__hip_atomic_fetch_add(myh + ((kr[i] >> shift) & 255u), 1u, __ATOMIC_RELAXED, __HIP_MEMORY_SCOPE_WORKGROUP); }
            }
            asm volatile("s_waitcnt lgkmcnt(0)" ::: "memory");
            const u32x4 ha = *(LAS u32x4*)(hist + 4 * lane), hc = *(LAS u32x4*)(hist + 256 + 4 * lane);
            const unsigned hb[4] = {ha.x + hc.x, ha.y + hc.y, ha.z + hc.z, ha.w + hc.w};
            const unsigned s = (hb[0] + hb[1]) + (hb[2] + hb[3]); unsigned S = s;
#pragma unroll
            for (int o = 1; o < 64; o <<= 1) { const unsigned t = __shfl_down(S, o); if (lane + o < 64) S += t; }
            const unsigned long long mk = __ballot((int)S >= need);
            const int L = 63 - __builtin_clzll(mk);
            unsigned cum = S - s; int d = 0, nd = need, cbv = 0; bool found = false;
#pragma unroll
            for (int b = 3; b >= 0; --b) { if (!found) { if ((int)(cum + hb[b]) >= need) { d = 4 * lane + b; nd = need - (int)cum; cbv = (int)hb[b]; found = true; } else cum += hb[b]; } }
            d = __builtin_amdgcn_readlane(d, L); need = __builtin_amdgcn_readlane(nd, L); const int cb = __builtin_amdgcn_readlane(cbv, L);
            prefix = (prefix << 8) | (unsigned)d;
            sfin = shift;
            done = (cb == need);
            if (!done && cb <= 64) { done = true; fast = true; ncand = cb; }
          }
        }
        LAS unsigned short* clist = (LAS unsigned short*)hist;
        const unsigned T = prefix; const int G0 = 256 - need;
        int baseG = 0, baseE = 0;
#pragma unroll
        for (int i = 0; i < 64; ++i) { if (i < n64) { const unsigned u = kr[i] >> sfin; const bool gt = u > T, eq = (u == T);
            const unsigned long long mg = __ballot(gt), me = __ballot(eq);
            const int pg = baseG + (int)__builtin_amdgcn_mbcnt_hi((unsigned)(mg >> 32), __builtin_amdgcn_mbcnt_lo((unsigned)mg, 0u));
            if (gt) sel[pg] = (unsigned short)(64 * i + lane);
            baseG += __popcll(mg);
            if (me != 0ull) {
                const int pe = baseE + (int)__builtin_amdgcn_mbcnt_hi((unsigned)(me >> 32), __builtin_amdgcn_mbcnt_lo((unsigned)me, 0u));
                if (fast) { if (eq) clist[pe] = (unsigned short)(64 * i + lane); }
                else if (eq && pe < need) sel[G0 + pe] = (unsigned short)(64 * i + lane);
                baseE += __popcll(me); } } }
        if (fast) {
            asm volatile("s_waitcnt lgkmcnt(0)" ::: "memory");
            const int ci = lane < ncand ? (int)clist[lane] : 0; const unsigned ck = lane < ncand ? sc[ci] : 0u;
            int rk = 0;
            for (int j = 0; j < ncand; ++j) { const unsigned kj = (unsigned)__builtin_amdgcn_readlane((int)ck, j); rk += (kj > ck || (kj == ck && j < lane)) ? 1 : 0; }
            if (lane < ncand && rk < need) sel[G0 + rk] = (unsigned short)ci;
        }
    }
    __syncthreads();
    const int n16 = lane & 15, g4 = lane >> 4;
    bf16x8 qb[4];
    { const bf16_t* qp = (const bf16_t*)(ws + WS_QR) + row * 2048 + n16 * 128 + 8 * g4;
      float x[4][8]; float ssq = 0.f;
#pragma unroll
      for (int ks = 0; ks < 4; ++ks) { const u32x4 raw = *(const u32x4*)(qp + 32 * ks); const unsigned w[4] = {raw.x, raw.y, raw.z, raw.w};
#pragma unroll
          for (int e = 0; e < 4; ++e) { x[ks][2 * e] = bf_lo(w[e]); x[ks][2 * e + 1] = bf_hi(w[e]); ssq += x[ks][2 * e] * x[ks][2 * e] + x[ks][2 * e + 1] * x[ks][2 * e + 1]; } }
      ssq += __shfl_xor(ssq, 16); ssq += __shfl_xor(ssq, 32);
      const float rs = 1.0f / sqrtf(ssq * (1.0f / 128.0f) + EPS);
      const float* qn = p.in[I_QN] + 8 * g4;
#pragma unroll
      for (int ks = 0; ks < 4; ++ks) { const f32x4 ga = *(const f32x4*)(qn + 32 * ks), gb = *(const f32x4*)(qn + 32 * ks + 4);
#pragma unroll
          for (int j = 0; j < 4; ++j) { x[ks][j] *= rs * ga[j]; x[ks][4 + j] *= rs * gb[j]; } }
      const float* cp = (const float*)(ws + WS_COSA) + tok * 64 + 8 * g4; const float* sp = (const float*)(ws + WS_SINA) + tok * 64 + 8 * g4;
#pragma unroll
      for (int ks = 0; ks < 2; ++ks) {
          const f32x4 c0 = *(const f32x4*)(cp + 32 * ks), c1 = *(const f32x4*)(cp + 32 * ks + 4), s0 = *(const f32x4*)(sp + 32 * ks), s1 = *(const f32x4*)(sp + 32 * ks + 4);
          const float cc[8] = {c0[0], c0[1], c0[2], c0[3], c1[0], c1[1], c1[2], c1[3]}, ss[8] = {s0[0], s0[1], s0[2], s0[3], s1[0], s1[1], s1[2], s1[3]};
          unsigned o1[4], o2[4];
#pragma unroll
          for (int e = 0; e < 4; ++e) {
              const float a0 = x[ks][2 * e], a1 = x[ks][2 * e + 1], b0 = x[ks + 2][2 * e], b1 = x[ks + 2][2 * e + 1];
              o1[e] = cvt_pk_bf16(a0 * cc[2 * e] - b0 * ss[2 * e], a1 * cc[2 * e + 1] - b1 * ss[2 * e + 1]);
              o2[e] = cvt_pk_bf16(a0 * ss[2 * e] + b0 * cc[2 * e], a1 * ss[2 * e + 1] + b1 * cc[2 * e + 1]);
          }
          const u32x4 p1 = (u32x4){o1[0], o1[1], o1[2], o1[3]}, p2 = (u32x4){o2[0], o2[1], o2[2], o2[3]};
          qb[ks] = __builtin_bit_cast(bf16x8, p1); qb[ks + 2] = __builtin_bit_cast(bf16x8, p2);
      } }
    const int nck = nsel >> 5;
    f32x4 lg[16];
    {
        LAS unsigned char* vb0 = lds + wave * (2 * VCH);
        const bf16_t* kbase = (const bf16_t*)(ws + WS_KN) + (size_t)b * SEQ * 128 + 8 * n16;
        LAS unsigned char* kput = vb0 + g4 * VROW + n16 * 16;
        const LAS unsigned char* kget = vb0 + n16 * VROW + g4 * 16;
        u32x4 kg[8];
#pragma unroll
        for (int i = 0; i < 8; ++i) kg[i] = *(const u32x4*)(kbase + (size_t)sel[g4 + 4 * i] * 128);
#pragma unroll
        for (int i = 0; i < 8; ++i) *(LAS u32x4*)(kput + 4 * i * VROW) = kg[i];
#pragma unroll
        for (int ck = 0; ck < 8; ++ck) {
            if (ck < nck) {
                const int buf = ck & 1;
                if (ck + 1 < nck) {
#pragma unroll
                    for (int i = 0; i < 8; ++i) kg[i] = *(const u32x4*)(kbase + (size_t)sel[32 * (ck + 1) + g4 + 4 * i] * 128);
                }
#pragma unroll
                for (int t = 0; t < 2; ++t) { f32x4 a = (f32x4){0.f, 0.f, 0.f, 0.f};
#pragma unroll
                    for (int ks = 0; ks < 4; ++ks) { const bf16x8 kf = *(const LAS bf16x8*)(kget + buf * VCH + t * 16 * VROW + ks * 64);
                        a = __builtin_amdgcn_mfma_f32_16x16x32_bf16(kf, qb[ks], a, 0, 0, 0); }
                    lg[2 * ck + t] = a; }
                if (ck + 1 < nck) {
#pragma unroll
                    for (int i = 0; i < 8; ++i) *(LAS u32x4*)(kput + (buf ^ 1) * VCH + 4 * i * VROW) = kg[i];
                }
            } else {
                lg[2 * ck] = (f32x4){-INFINITY, -INFINITY, -INFINITY, -INFINITY}; lg[2 * ck + 1] = (f32x4){-INFINITY, -INFINITY, -INFINITY, -INFINITY};
            }
        }
    }
    float mx = -INFINITY;
#pragma unroll
    for (int kt = 0; kt < 16; ++kt) mx = fmaxf(mx, fmaxf(fmaxf(lg[kt][0], lg[kt][1]), fmaxf(lg[kt][2], lg[kt][3])));
    mx = fmaxf(mx, __shfl_xor(mx, 16)); mx = fmaxf(mx, __shfl_xor(mx, 32));
    const float cexp = 0.08838834764831845f * LOG2E;
    float sum = 0.f;
    bf16x8 pf[8];
#pragma unroll
    for (int ck = 0; ck < 8; ++ck) {
        float pv[8];
#pragma unroll
        for (int r = 0; r < 4; ++r) { pv[r] = __builtin_amdgcn_exp2f((lg[2 * ck][r] - mx) * cexp); pv[4 + r] = __builtin_amdgcn_exp2f((lg[2 * ck + 1][r] - mx) * cexp); }
#pragma unroll
        for (int r = 0; r < 8; ++r) sum += pv[r];
        const u32x4 pw = (u32x4){cvt_pk_bf16(pv[0], pv[1]), cvt_pk_bf16(pv[2], pv[3]), cvt_pk_bf16(pv[4], pv[5]), cvt_pk_bf16(pv[6], pv[7])};
        pf[ck] = __builtin_bit_cast(bf16x8, pw);
    }
    sum += __shfl_xor(sum, 16); sum += __shfl_xor(sum, 32);
    const float inv = 1.0f / sum;
    f32x4 oacc[8];
#pragma unroll
    for (int c = 0; c < 8; ++c) oacc[c] = (f32x4){0.f, 0.f, 0.f, 0.f};
    {
        LAS unsigned char* vb0 = lds + wave * (2 * VCH);
        const bf16_t* vbase = (const bf16_t*)(ws + WS_VB) + (size_t)b * SEQ * 128 + 8 * n16;
        LAS unsigned char* vput = vb0 + g4 * VROW + n16 * 16;
        const LAS s16x4* tb = (const LAS s16x4*)(vb0 + (4 * g4 + (n16 >> 2)) * VROW + 8 * (n16 & 3));
        u32x4 vr[8];
#pragma unroll
        for (int i = 0; i < 8; ++i) vr[i] = *(const u32x4*)(vbase + (size_t)sel[g4 + 4 * i] * 128);
#pragma unroll
        for (int i = 0; i < 8; ++i) *(LAS u32x4*)(vput + 4 * i * VROW) = vr[i];
#pragma unroll
        for (int ck = 0; ck < 8; ++ck) {
            if (ck < nck) {
                const int buf = ck & 1;
                if (ck + 1 < nck) {
#pragma unroll
                    for (int i = 0; i < 8; ++i) vr[i] = *(const u32x4*)(vbase + (size_t)sel[32 * (ck + 1) + g4 + 4 * i] * 128);
                }
#pragma unroll
                for (int c = 0; c < 8; ++c) {
                    const s16x4 r0 = __builtin_amdgcn_ds_read_tr16_b64_v4i16((LAS s16x4*)(tb + (buf * VCH + c * 32) / 8));
                    const s16x4 r1 = __builtin_amdgcn_ds_read_tr16_b64_v4i16((LAS s16x4*)(tb + (buf * VCH + 16 * VROW + c * 32) / 8));
                    const bf16x8 av = (bf16x8){r0[0], r0[1], r0[2], r0[3], r1[0], r1[1], r1[2], r1[3]};
                    oacc[c] = __builtin_amdgcn_mfma_f32_16x16x32_bf16(av, pf[ck], oacc[c], 0, 0, 0);
                }
                if (ck + 1 < nck) {
#pragma unroll
                    for (int i = 0; i < 8; ++i) *(LAS u32x4*)(vput + (buf ^ 1) * VCH + 4 * i * VROW) = vr[i];
                }
            }
        }
    }
    { bf16_t* yb = (bf16_t*)(ws + WS_YB) + row * 2048 + n16 * 128 + 4 * g4;
#pragma unroll
      for (int c = 0; c < 8; ++c) { u32x2 w; w.x = cvt_pk_bf16(oacc[c][0] * inv, oacc[c][1] * inv); w.y = cvt_pk_bf16(oacc[c][2] * inv, oacc[c][3] * inv); *(u32x2*)(yb + 16 * c) = w; } }
    __syncthreads();
}

constexpr int NPHASE = 10;
__global__ void __launch_bounds__(512, 2) mk_fwd(Params p) {
    extern __shared__ __attribute__((aligned(16))) unsigned char lds_raw[];
    LAS unsigned char* lds = (LAS unsigned char*)lds_raw;
    const int tid = threadIdx.x, lane = tid & 63, wave = __builtin_amdgcn_readfirstlane(tid >> 6);
    const int G = (int)gridDim.x;
    unsigned char* ws = p.ws;
    volatile LAS unsigned* MISC = (volatile LAS unsigned*)(lds + MISC_OFF);
    if (tid < 32) MISC[tid] = 0u;
    __syncthreads();
    const XcdBarrier bar = xcd_barrier_post(g_bar, MISC + 8);
    const int lo = p.ph_lo, hi = p.ph_hi;
#define IN(k) (lo <= (k) && (k) < hi)
#define SEAM(k) do { if (IN(k) && IN((k) + 1)) xcd_barrier(bar); } while (0)
    bf16_t* R1 = (bf16_t*)(ws + WS_R1);

    if (IN(0)) { phase_prologue(p, lds, tid, lane, wave); }
    SEAM(0);
    if (IN(0) && IN(1)) {
        if (tid == 0) { bool ok = (G % 8 == 0) && bar.x < 8u;
            for (int j = 0; j < 16; ++j) { const unsigned cj = xb_ld(&g_bar[XB_XCNT(j)]); ok = ok && (cj == (j < 8 ? (unsigned)(G / 8) : 0u)); }
            MISC[11] = ok ? (MISC[10] * 8u + bar.x) : (unsigned)blockIdx.x; }
        __syncthreads();
    } else { if (tid == 0) MISC[11] = (unsigned)blockIdx.x; __syncthreads(); }
    const int cid = (int)MISC[11];
    if (IN(1)) {
        pg8::Gemm g{R1, (const bf16_t*)(ws + WS_W13A), nullptr, nullptr, DM}; pg8::TileOrder<1> S; S.init(MROWS, 2 * DFF, G, cid);
        EpiSwiGLU<USE_FP8_DOWN1 != 0> E{(bf16_t*)(ws + WS_R2), nullptr, 1.0f};
        pg8::gemm_phase(lds, g, S, E);
        {
            constexpr int I_W13 = (DM / 64) * (2 * DFF / 32), I_W2 = (DFF / 64) * (DM / 32);
            const int nwg = (MROWS / 256) * (2 * DFF / 256), rem = nwg % G, c = cid;
            if (rem == 0 || c >= rem) { const int workers = rem == 0 ? G : G - rem, rank = rem == 0 ? c : c - rem;
                conv_items(p, (LAS float*)(lds + wave * 16384), 2 * I_W13 + rank * 8 + wave, workers * 8, 2 * I_W13 + I_W2, 0, 0, lane); }
        }
    }
    SEAM(1);
    if (IN(2)) {
        pg8::Gemm g{(const bf16_t*)(ws + WS_R2), (const bf16_t*)(ws + WS_W2A), nullptr, nullptr, USE_FP8_DOWN1 ? DFF / 2 : DFF}; pg8::TileOrder<1> S; S.init(MROWS, DM, G, cid);
        using EpiH1 = EpiRes<false, false, true, true, true>;
        EpiH1 E{p.in[I_X], nullptr, R1, (float*)(ws + WS_SS2P), ws + WS_H1B8, USE_FP8_DOWN1 ? 0.5f / (G8_SCALE * W8_SCALE) : 0.5f};
        pg8::gemm_phase<EpiH1, pg8::TileOrder<1>, USE_FP8_DOWN1 != 0>(lds, g, S, E);
    }
    SEAM(2);
    if (IN(3)) {
        LAS float* rsl = (LAS float*)(lds + LDS_RS);
        { pg8::TileOrder<1> S0; S0.init(MROWS, NIN_A, G, cid); Unit u0; S0.next(0, u0); panel_rs((const float*)(ws + WS_SS2P), u0.pm, rsl, tid); }
        { pg8::Gemm g{R1, (const bf16_t*)(ws + WS_WIN), nullptr, nullptr, DM}; pg8::TileOrder<1> S; S.init(MROWS, NIN_A, G, cid);
          EpiIn<0> E{rsl, (bf16_t*)(ws + WS_U), (bf16_t*)(ws + WS_V), (bf16_t*)(ws + WS_QR), (bf16_t*)(ws + WS_QIR), (float*)(ws + WS_KVR), ws + WS_R3, p.in[I_GBIAS], (float*)(ws + WS_SSVP)};
          pg8::gemm_phase(lds, g, S, E); }
        { pg8::Gemm g{(const bf16_t*)(ws + WS_H1B8), (const bf16_t*)(ws + WS_WINB8), nullptr, nullptr, DM / 2};
          EpiIn<1> E{rsl, (bf16_t*)(ws + WS_U), (bf16_t*)(ws + WS_V), (bf16_t*)(ws + WS_QR), (bf16_t*)(ws + WS_QIR), (float*)(ws + WS_KVR), ws + WS_R3, p.in[I_GBIAS], (float*)(ws + WS_SSVP)};
          pg8::SplitOrTile<MROWS, NIN_B, 5, 7> S{G, cid};
          pg8::gemm_phase<EpiIn<1>, pg8::SplitOrTile<MROWS, NIN_B, 5, 7>, true>(lds, g, S, E); }
    }
    SEAM(3);
    if (IN(4)) { phase_post(p, lane, wave); }
    SEAM(4);
    if (IN(5)) {
        gmlp_units(p, lds, G, tid, lane, wave);
        for (int pr = (int)blockIdx.x; pr < 1024; pr += G) { const int b = pr >> 8, j = pr & 255; dsa_unit(p, lds, b, j, tid, lane, wave); dsa_unit(p, lds, b, 511 - j, tid, lane, wave); }
    }
    SEAM(5);
    if (IN(6)) {
        pg8::Gemm g{(const bf16_t*)(ws + WS_YA), (const bf16_t*)(ws + WS_WA), (const bf16_t*)(ws + WS_YB), (const bf16_t*)(ws + WS_WB), GW}; pg8::TileOrder<2> S; S.init(MROWS, DM, G, cid);
        EpiMerge E{ws + WS_R3, (bf16_t*)p.out};
        pg8::gemm_phase(lds, g, S, E);
    }
    SEAM(6);
    if (IN(7)) {
        pg8::Gemm g{(const bf16_t*)p.out, (const bf16_t*)(ws + WS_WOUT), nullptr, nullptr, DM}; pg8::TileOrder<1> S; S.init(MROWS, DM, G, cid);
        using EpiH2 = EpiRes<true, false, true, USE_FP8_UP2 != 0, true>;
        EpiH2 E{R1, nullptr, (bf16_t*)(ws + WS_R3), (float*)(ws + WS_SS3P), ws + WS_H2B8, 1.0f};
        pg8::gemm_phase(lds, g, S, E);
    }
    SEAM(7);
    if (IN(8)) {
        pg8::TileOrder<1> S; S.init(MROWS, 2 * DFF, G, cid);
        LAS float* rsl = (LAS float*)(lds + LDS_RS);
        { Unit u0; S.next(0, u0); panel_rs((const float*)(ws + WS_SS3P), u0.pm, rsl, tid); }
        if (USE_FP8_UP2) {
            pg8::Gemm g{(const bf16_t*)(ws + WS_H2B8), (const bf16_t*)(ws + WS_W13B), nullptr, nullptr, DM / 2};
            EpiSwiGLU<USE_FP8_DOWN != 0> E{(bf16_t*)(ws + WS_R2), rsl, 1.0f / (H8_SCALE * WIN8_SCALE)};
            pg8::gemm_phase<EpiSwiGLU<USE_FP8_DOWN != 0>, pg8::TileOrder<1>, USE_FP8_UP2 != 0>(lds, g, S, E);
        } else {
            pg8::Gemm g{(const bf16_t*)(ws + WS_R3), (const bf16_t*)(ws + WS_W13B), nullptr, nullptr, DM};
            EpiSwiGLU<USE_FP8_DOWN != 0> E{(bf16_t*)(ws + WS_R2), rsl, 1.0f};
            pg8::gemm_phase(lds, g, S, E);
        }
        {
            constexpr int I_W13 = (DM / 64) * (2 * DFF / 32), I_W2 = (DFF / 64) * (DM / 32);
            const int nwg = (MROWS / 256) * (2 * DFF / 256), rem = nwg % G, c = cid;
            if (rem == 0 || c >= rem) { const int workers = rem == 0 ? G : G - rem, rank = rem == 0 ? c : c - rem;
                conv_items(p, (LAS float*)(lds + wave * 16384), 2 * I_W13 + I_W2 + I_W2 / 2 + rank * 8 + wave, workers * 8, 2 * I_W13 + 2 * I_W2, 0, 0, lane); }
        }
    }
    SEAM(8);
    if (IN(9)) {
        pg8::Gemm g{(const bf16_t*)(ws + WS_R2), (const bf16_t*)(ws + WS_W2B), nullptr, nullptr, USE_FP8_DOWN ? DFF / 2 : DFF}; pg8::TileOrder<1> S; S.init(MROWS, DM, G, cid);
        using EpiOut = EpiRes<true, true, false, false, false>;
        EpiOut E{(const bf16_t*)(ws + WS_R3), p.out, nullptr, nullptr, nullptr, USE_FP8_DOWN ? 0.5f / (G8_SCALE * W8_SCALE) : 0.5f};
        pg8::gemm_phase<EpiOut, pg8::TileOrder<1>, USE_FP8_DOWN != 0>(lds, g, S, E);
    }
    {
        if (xb_ld(&g_bar[XB_TMO]) != 0u) { const float q = __builtin_nanf(""); asm volatile("s_waitcnt vmcnt(0)" ::: "memory"); __syncthreads();
            for (size_t i = (size_t)blockIdx.x * 512 + tid; i < (size_t)MROWS * DM / 4; i += (size_t)G * 512) ((f32x4*)p.out)[i] = (f32x4){q, q, q, q}; }
        xcd_barrier_retire(g_bar);
    }
#undef IN
#undef SEAM
}

extern "C" void kernel_launch(void* const* d_in, const int* in_sizes, int n_in, void* d_out, int out_size, void* d_ws, size_t ws_size, hipStream_t stream) {
    static int grid = 0;
    if (grid == 0) {
        if (n_in != 21 || out_size != MROWS * DM || ws_size < WS_END) { fprintf(stderr, "kernel_launch: unexpected shapes (n_in %d, out %d, ws %zu); nothing launched\n", n_in, out_size, ws_size); grid = -1; return; }
        int dev = 0, cus = 0, per_cu = 0;
        if (hipGetDevice(&dev) != hipSuccess || hipDeviceGetAttribute(&cus, hipDeviceAttributeMultiprocessorCount, dev) != hipSuccess) { grid = -1; return; }
        if (hipFuncSetAttribute((const void*)mk_fwd, hipFuncAttributeMaxDynamicSharedMemorySize, LDS_BYTES) != hipSuccess) { fprintf(stderr, "kernel_launch: hipFuncSetAttribute failed\n"); grid = -1; return; }
        if (hipOccupancyMaxActiveBlocksPerMultiprocessor(&per_cu, (const void*)mk_fwd, 512, LDS_BYTES) != hipSuccess || per_cu < 1)
            fprintf(stderr, "kernel_launch: occupancy query reports %d workgroups per CU\n", per_cu);
        (void)hipGetLastError();
        grid = cus;
    }
    if (grid < 0) return;
    Params a{};
    for (int i = 0; i < 21; ++i) a.in[i] = (const float*)d_in[i];
    a.out = (float*)d_out; a.ws = (unsigned char*)d_ws;
    a.ph_lo = 0; a.ph_hi = NPHASE;
    hipLaunchKernelGGL(mk_fwd, dim3(grid), dim3(512), LDS_BYTES, stream, a);
}
```
